# Optimizing an MI355X kernel written in HIP

```python
import math
import jax, jax.numpy as jnp
from jax import lax
import numpy as np

D_MODEL = 1024
BATCH = 32
SEQ = 256
DEPTH = 4
DEC_BATCH = 2
DEC_SEQ = 2048
PAST_LEN = 512

GRID_W = 64
N_EVEN = (DEPTH + 1) // 2
N_ODD = DEPTH // 2
A_WIDTH = D_MODEL // 2
A_HEADS = 4
A_DV = A_WIDTH // A_HEADS
A_DK = A_DV // 2
A_QK = A_HEADS * A_DK
A_RANK = 16
A_GATE_NORM = 16.0
GLA_CHUNK = 16
B_WIDTH = D_MODEL - A_WIDTH
POOL_WINDOWS = (2, 4, 8, 16)
B_GROUPS = len(POOL_WINDOWS)
B_GW = B_WIDTH // B_GROUPS
A_SPLITS = (A_QK, A_QK, A_WIDTH, A_WIDTH, 2 * A_RANK, B_WIDTH)
C_HEADS = 8
C_DK = D_MODEL // C_HEADS
C_DV = C_DK
C_WIDTH = C_HEADS * C_DV
SHORT_CONV = 3
DN_CHUNK = 64
C_SPLITS = (3 * C_WIDTH, C_WIDTH, 2 * C_HEADS, 2 * C_HEADS)
D_FF = 2816
FFN_CONV = 3
N_MOD = 6
ALPHA = (2 * DEPTH) ** 0.25
BETA_INIT = (8 * DEPTH) ** -0.25
EPS = 1e-6

kernel_name = "bidir_gla_pool_deltanet_convffn_diffusion_step"

F32 = jnp.float32


def _split(h, sizes):
    idx, acc = [], 0
    for s in sizes[:-1]:
        acc += s
        idx.append(acc)
    return jnp.split(h, idx, axis=-1)


def _layernorm(x, g, b):
    xf = x.astype(F32)
    mu = xf.mean(-1, keepdims=True)
    var = jnp.mean(jnp.square(xf - mu), -1, keepdims=True)
    return ((xf - mu) * lax.rsqrt(var + EPS) * g.astype(F32) + b.astype(F32)).astype(x.dtype)


def _rmsnorm_f32(x, g):
    xf = x.astype(F32)
    return xf * lax.rsqrt(jnp.mean(xf * xf, -1, keepdims=True) + EPS) * g.astype(F32)


def _l2norm(x):
    return x * lax.rsqrt(jnp.sum(x * x, -1, keepdims=True) + EPS)


def _dwconv(x, w):
    k = w.shape[0]
    p = k // 2
    L = x.shape[1]
    xp = jnp.pad(x, ((0, 0), (p, p), (0, 0)))
    return sum(xp[:, i:i + L] * w[i] for i in range(k))


def _grid_pos_embed(n_tokens):
    rows = n_tokens // GRID_W
    r = jnp.broadcast_to(jnp.arange(rows, dtype=F32)[:, None], (rows, GRID_W)).reshape(-1)
    col = jnp.broadcast_to(jnp.arange(GRID_W, dtype=F32)[None, :], (rows, GRID_W)).reshape(-1)
    quarter = D_MODEL // 4
    freq = jnp.exp(-math.log(10000.0) * jnp.arange(quarter, dtype=F32) / quarter)
    ra, ca = r[:, None] * freq, col[:, None] * freq
    return jnp.concatenate([jnp.sin(ra), jnp.cos(ra), jnp.sin(ca), jnp.cos(ca)], -1)


def _gla_chunk(q, k, v, g, s0):
    B_, H, L, dk = q.shape
    dv = v.shape[-1]
    n = L // GLA_CHUNK
    sp = lambda t: t.reshape(B_, H, n, GLA_CHUNK, t.shape[-1])
    q, k, v, g = sp(q), sp(k), sp(v), sp(g)
    b = jnp.cumsum(g, axis=3)
    b_last = b[:, :, :, -1]
    mask = jnp.tril(jnp.ones((GLA_CHUNK, GLA_CHUNK), bool))[:, :, None]
    dec = jnp.exp(jnp.where(mask, b[:, :, :, :, None, :] - b[:, :, :, None, :, :], -jnp.inf))
    att = jnp.einsum('bhnid,bhnjd,bhnijd->bhnij', q, k, dec)
    o_intra = jnp.einsum('bhnij,bhnjv->bhniv', att, v)
    qg = q * jnp.exp(b)
    kd = k * jnp.exp(b_last[:, :, :, None, :] - b)

    def step(s, xs):
        qg_c, kd_c, v_c, d_c = xs
        o = jnp.einsum('bhid,bhdv->bhiv', qg_c, s)
        s = s * d_c[..., None] + jnp.einsum('bhid,bhiv->bhdv', kd_c, v_c)
        return s, o

    xs = (jnp.moveaxis(qg, 2, 0), jnp.moveaxis(kd, 2, 0), jnp.moveaxis(v, 2, 0),
          jnp.moveaxis(jnp.exp(b_last), 2, 0))
    s_fin, o_inter = lax.scan(step, s0, xs)
    o = o_intra + jnp.moveaxis(o_inter, 0, 2)
    return o.reshape(B_, H, L, dv), s_fin


def _delta_chunk(q, k, v, g, beta, s0):
    B_, H, L, dk = q.shape
    dv = v.shape[-1]
    C = DN_CHUNK
    n = L // C
    q = q.reshape(B_, H, n, C, dk)
    k = k.reshape(B_, H, n, C, dk)
    v = v.reshape(B_, H, n, C, dv)
    g = g.reshape(B_, H, n, C)
    beta = beta.reshape(B_, H, n, C)
    b = jnp.cumsum(g, axis=-1)
    incl = jnp.tril(jnp.ones((C, C), bool))
    strict = jnp.tril(jnp.ones((C, C), bool), k=-1)
    ld = jnp.exp(jnp.where(incl, b[..., :, None] - b[..., None, :], -jnp.inf))
    kb = k * beta[..., None]
    kk = jnp.where(strict, jnp.einsum('bhnid,bhnjd->bhnij', kb, k) * ld, 0.0)
    eye = jnp.eye(C, dtype=F32)
    t = lax.linalg.triangular_solve(eye + kk, jnp.broadcast_to(eye, kk.shape),
                                    left_side=True, lower=True, unit_diagonal=True)
    u = jnp.einsum('bhnij,bhnjv->bhniv', t, v * beta[..., None])
    w = jnp.einsum('bhnij,bhnjd->bhnid', t, kb * jnp.exp(b)[..., None])
    aqk = jnp.einsum('bhnid,bhnjd->bhnij', q, k) * ld
    qd = q * jnp.exp(b)[..., None]
    kd = k * jnp.exp(b[..., -1:] - b)[..., None]
    dec = jnp.exp(b[..., -1])

    def step(s, xs):
        u_c, w_c, q_c, a_c, k_c, d_c = xs
        v_new = u_c - jnp.einsum('bhid,bhdv->bhiv', w_c, s)
        o = jnp.einsum('bhid,bhdv->bhiv', q_c, s) + jnp.einsum('bhij,bhjv->bhiv', a_c, v_new)
        s = s * d_c[..., None, None] + jnp.einsum('bhid,bhiv->bhdv', k_c, v_new)
        return s, o

    xs = tuple(jnp.moveaxis(a, 2, 0) for a in (u, w, qd, aqk, kd, dec))
    s_fin, o = lax.scan(step, s0, xs)
    return jnp.moveaxis(o, 0, 2).reshape(B_, H, L, dv), s_fin


def _pool_mix(u, w_grp, scale):
    B_, L, _ = u.shape
    uf = u.astype(F32).reshape(B_, L, B_GROUPS, B_GW)
    cs = jnp.pad(jnp.cumsum(uf, axis=1), ((0, 0), (1, 0), (0, 0), (0, 0)))
    pos = jnp.arange(L)
    outs = []
    for gi, win in enumerate(POOL_WINDOWS):
        lo = win // 2
        hi = win - 1 - lo
        start = jnp.clip(pos - lo, 0, L)
        end = jnp.clip(pos + hi + 1, 0, L)
        csg = cs[:, :, gi]
        cnt = (end - start).astype(F32)[None, :, None]
        outs.append((csg[:, end] - csg[:, start]) / cnt - uf[:, :, gi])
    pooled = jnp.stack(outs, axis=2).astype(u.dtype)
    mixed = jnp.einsum('blgc,gcd->blgd', pooled, w_grp)
    return mixed.reshape(B_, L, B_WIDTH) * scale


def _heads(t, d):
    B_, L = t.shape[0], t.shape[1]
    return t.reshape(B_, L, -1, d).transpose(0, 2, 1, 3).astype(F32)


def _gla_pool_mixer(u, s0, w_in, w_gate, b_gate, norm_g, pool_w, pool_s, w_out):
    B_, L, _ = u.shape
    q, k, v, r, lr, pz = _split(u @ w_in, A_SPLITS)
    qh = _heads(q, A_DK) * (A_DK ** -0.5)
    kh = _heads(k, A_DK)
    vh = _heads(v, A_DV)
    lr = lr.astype(F32).reshape(B_, L, 2, A_RANK)
    glog = jax.nn.log_sigmoid(jnp.einsum('blzr,zrk->blzk', lr, w_gate.astype(F32)) + b_gate.astype(F32)) / A_GATE_NORM
    g_f = _heads(glog[:, :, 0], A_DK)
    g_b = _heads(glog[:, :, 1], A_DK)
    fl = lambda t: jnp.flip(t, axis=2)
    o_f, s_f = _gla_chunk(qh, kh, vh, g_f, s0[:, 0])
    o_b, s_b = _gla_chunk(fl(qh), fl(kh), fl(vh), fl(g_b), s0[:, 1])
    o = (o_f + fl(o_b)).transpose(0, 2, 1, 3)
    o = _rmsnorm_f32(o, norm_g).reshape(B_, L, A_WIDTH).astype(u.dtype) * jax.nn.silu(r)
    p = _pool_mix(pz, pool_w, pool_s)
    y = jnp.concatenate([o, p], axis=-1) @ w_out
    return y, jnp.stack([s_f, s_b], axis=1)


def _deltanet_mixer(u, s0, w_in, conv_w, a_log, dt_bias, norm_g, w_out):
    B_, L, _ = u.shape
    qkv, z, a, bt = _split(u @ w_in, C_SPLITS)
    qkv = jax.nn.silu(_dwconv(qkv, conv_w))
    q, k, v = jnp.split(qkv, 3, axis=-1)
    qh = _l2norm(_heads(q, C_DK)) * (C_DK ** -0.5)
    kh = _l2norm(_heads(k, C_DK))
    vh = _heads(v, C_DV)
    a = a.astype(F32).reshape(B_, L, 2, C_HEADS)
    g = -jnp.exp(a_log.astype(F32)) * jax.nn.softplus(a + dt_bias.astype(F32))
    beta = jax.nn.sigmoid(bt.astype(F32).reshape(B_, L, 2, C_HEADS))
    g = g.transpose(2, 0, 3, 1)
    beta = beta.transpose(2, 0, 3, 1)
    fl = lambda t: jnp.flip(t, axis=2)
    o_f, s_f = _delta_chunk(qh, kh, vh, g[0], beta[0], s0[:, 0])
    o_b, s_b = _delta_chunk(fl(qh), fl(kh), fl(vh), fl(g[1]), fl(beta[1]), s0[:, 1])
    o = (o_f + fl(o_b)).transpose(0, 2, 1, 3)
    o = _rmsnorm_f32(o, norm_g).reshape(B_, L, C_WIDTH).astype(u.dtype) * jax.nn.silu(z)
    return o @ w_out, jnp.stack([s_f, s_b], axis=1)


def _conv_ffn(u, w_up, conv_w, w_down):
    h = _dwconv(u @ w_up, conv_w)
    a, gt = jnp.split(h, 2, axis=-1)
    return (jax.nn.silu(gt) * a) @ w_down


def _trunk(x, cond, gla_s0, dn_s0, w):
    sc = jax.nn.silu(cond.astype(F32)).astype(x.dtype)
    gla_out, dn_out = [], []
    for l in range(DEPTH):
        mod = (sc @ w['w_mod'][l] + w['b_mod'][l])[:, None, :]
        sh1, sc1, g1, sh2, sc2, g2 = jnp.split(mod, N_MOD, axis=-1)
        u = x * (1 + sc1) + sh1
        if l % 2 == 0:
            e = l // 2
            y, st = _gla_pool_mixer(u, gla_s0[:, e], w['a_w_in'][e], w['a_w_gate'][e], w['a_b_gate'][e],
                                    w['a_norm'][e], w['b_proj'][e], w['b_scale'][e], w['a_w_out'][e])
            gla_out.append(st)
        else:
            o_ = l // 2
            y, st = _deltanet_mixer(u, dn_s0[:, o_], w['c_w_in'][o_], w['c_conv'][o_], w['c_a_log'][o_],
                                    w['c_dt_bias'][o_], w['c_norm'][o_], w['c_w_out'][o_])
            dn_out.append(st)
        x = _layernorm(ALPHA * x + g1 * y.astype(x.dtype), w['ln1_g'][l], w['ln1_b'][l])
        u = x * (1 + sc2) + sh2
        f = _conv_ffn(u, w['f_w_up'][l], w['f_conv'][l], w['f_w_down'][l])
        x = _layernorm(ALPHA * x + g2 * f, w['ln2_g'][l], w['ln2_b'][l])
    return x, jnp.stack(gla_out, axis=1), jnp.stack(dn_out, axis=1)


def setup_inputs(seed: int = 0) -> dict:
    key = jax.random.key(seed)
    ks = jax.random.split(key, 32)
    nrm = lambda i, shape, s: jax.random.normal(ks[i], shape, F32) * s
    d_in_a = sum(A_SPLITS)
    d_in_c = sum(C_SPLITS)
    dt = jnp.exp(jax.random.uniform(ks[21], (N_ODD, 2, C_HEADS), F32) * (math.log(0.1) - math.log(0.001)) + math.log(0.001))
    return {
        "x_prompt": nrm(0, (BATCH, SEQ, D_MODEL), 1.0),
        "x_sample": nrm(1, (DEC_BATCH, DEC_SEQ, D_MODEL), 1.0),
        "state_gla": nrm(2, (DEC_BATCH, N_EVEN, 2, A_HEADS, A_DK, A_DV), 0.5),
        "state_dn": nrm(3, (DEC_BATCH, N_ODD, 2, C_HEADS, C_DK, C_DV), 1.0),
        "c": nrm(4, (DEC_BATCH, D_MODEL), 1.0),
        "c_ctx": nrm(5, (D_MODEL,), 1.0),
        "w_mod": nrm(6, (DEPTH, D_MODEL, N_MOD * D_MODEL), 0.5 * D_MODEL ** -0.5),
        "b_mod": nrm(7, (DEPTH, N_MOD * D_MODEL), 0.02),
        "ln1_g": 1.0 + nrm(8, (DEPTH, D_MODEL), 0.02),
        "ln1_b": nrm(9, (DEPTH, D_MODEL), 0.02),
        "ln2_g": 1.0 + nrm(10, (DEPTH, D_MODEL), 0.02),
        "ln2_b": nrm(11, (DEPTH, D_MODEL), 0.02),
        "a_w_in": nrm(12, (N_EVEN, D_MODEL, d_in_a), D_MODEL ** -0.5),
        "a_w_gate": nrm(13, (N_EVEN, 2, A_RANK, A_QK), A_RANK ** -0.5),
        "a_b_gate": nrm(14, (N_EVEN, 2, A_QK), 0.02),
        "a_norm": 1.0 + nrm(15, (N_EVEN, A_DV), 0.02),
        "b_proj": nrm(16, (N_EVEN, B_GROUPS, B_GW, B_GW), B_GW ** -0.5),
        "b_scale": 1.0 + nrm(17, (N_EVEN, B_WIDTH), 0.02),
        "a_w_out": nrm(18, (N_EVEN, A_WIDTH + B_WIDTH, D_MODEL), BETA_INIT * (A_WIDTH + B_WIDTH) ** -0.5),
        "c_w_in": nrm(19, (N_ODD, D_MODEL, d_in_c), D_MODEL ** -0.5),
        "c_conv": nrm(20, (N_ODD, SHORT_CONV, 3 * C_WIDTH), SHORT_CONV ** -0.5),
        "c_a_log": jnp.log(jax.random.uniform(ks[22], (N_ODD, 2, C_HEADS), F32, 1.0, 16.0)),
        "c_dt_bias": dt + jnp.log(-jnp.expm1(-dt)),
        "c_norm": 1.0 + nrm(23, (N_ODD, C_DV), 0.02),
        "c_w_out": nrm(24, (N_ODD, C_WIDTH, D_MODEL), BETA_INIT * C_WIDTH ** -0.5),
        "f_w_up": nrm(25, (DEPTH, D_MODEL, 2 * D_FF), D_MODEL ** -0.5),
        "f_conv": nrm(26, (DEPTH, FFN_CONV, 2 * D_FF), FFN_CONV ** -0.5),
        "f_w_down": nrm(27, (DEPTH, D_FF, D_MODEL), BETA_INIT * D_FF ** -0.5),
    }


def reference(x_prompt, x_sample, state_gla, state_dn, c, c_ctx, w_mod, b_mod, ln1_g, ln1_b, ln2_g, ln2_b,
              a_w_in, a_w_gate, a_b_gate, a_norm, b_proj, b_scale, a_w_out,
              c_w_in, c_conv, c_a_log, c_dt_bias, c_norm, c_w_out, f_w_up, f_conv, f_w_down):
    w = dict(w_mod=w_mod, b_mod=b_mod, ln1_g=ln1_g, ln1_b=ln1_b, ln2_g=ln2_g, ln2_b=ln2_b,
             a_w_in=a_w_in, a_w_gate=a_w_gate, a_b_gate=a_b_gate, a_norm=a_norm, b_proj=b_proj,
             b_scale=b_scale, a_w_out=a_w_out, c_w_in=c_w_in, c_conv=c_conv, c_a_log=c_a_log,
             c_dt_bias=c_dt_bias, c_norm=c_norm, c_w_out=c_w_out, f_w_up=f_w_up, f_conv=f_conv,
             f_w_down=f_w_down)
    nb = x_prompt.shape[0]
    g0 = jnp.zeros((nb, N_EVEN, 2, A_HEADS, A_DK, A_DV), F32)
    d0 = jnp.zeros((nb, N_ODD, 2, C_HEADS, C_DK, C_DV), F32)
    y_prompt, new_gla, new_dn = _trunk(x_prompt, c_ctx[None, :], g0, d0, w)
    pe = _grid_pos_embed(x_sample.shape[1]).astype(x_sample.dtype)
    y_sample, _, _ = _trunk(x_sample + pe, c, state_gla.astype(F32), state_dn.astype(F32), w)
    return (y_prompt, y_sample, new_gla.astype(x_prompt.dtype), new_dn.astype(x_prompt.dtype))
```

```cpp
#include <hip/hip_runtime.h>
#include <cstdio>
#include <cstdint>
namespace pg8 {
#define PG8_LAS __attribute__((address_space(3)))
typedef unsigned short bf16_t;
typedef short bf16x8 __attribute__((ext_vector_type(8)));
typedef float f32x4 __attribute__((ext_vector_type(4)));
typedef unsigned u32x4 __attribute__((ext_vector_type(4)));
constexpr int BM = 256, BK = 64, HALF = 128, HTB = HALF * BK * 2  , STAGE_BYTES = 8 * HTB, NXCD = 8, WGM = 8;

__host__ __device__ __forceinline__ int lds_byte(int r, int c) { const int st = (r >> 4) * 2 + (c >> 5), rr = r & 15, cc = c & 31, ob = rr * 64 + cc * 2; return st * 1024 + (ob ^ (((ob >> 9) & 1) << 5)); }
__host__ __device__ __forceinline__ void stage_rc(int b, int& R, int& C) { const int st = b / 1024, sb = b % 1024, swz = sb ^ (((sb >> 9) & 1) << 5); R = (st >> 1) * 16 + swz / 64; C = (st & 1) * 32 + (swz % 64) / 2; }
__host__ __device__ __forceinline__ int perm32(int rho) { const int n = rho >> 4, i = rho & 15; return 8 * (i >> 2) + 4 * n + (i & 3); }

struct Unit { int pm, pn; };
struct Gemm { const bf16_t* A; const bf16_t* Bt; int M, N, K; };

struct StaticOrder {
    int nM, nN, nwg, G, c;
    __host__ __device__ void init(int M, int N, int G_, int c_) { nM = M / BM; nN = N / BM; nwg = nM * nN; G = G_; c = c_; }
    __host__ __device__ bool next(int i, Unit& u) const {
        const long L = (long)i * G + c; if (L >= nwg) return false;
        int wgid = (int)L; { const int q = nwg / NXCD, r = nwg % NXCD, xcd = wgid % NXCD, off = wgid / NXCD; wgid = (xcd < r ? xcd * (q + 1) : r * (q + 1) + (xcd - r) * q) + off; }
        const int nig = WGM * nN, gid = wgid / nig, fm = gid * WGM, gsz = (nM - fm) < WGM ? (nM - fm) : WGM;
        u.pm = fm + ((wgid % nig) % gsz); u.pn = (wgid % nig) / gsz; return true;
    }
    __device__ __forceinline__ void a_ready(const Unit&) const {}
    __device__ __forceinline__ void done(const Unit&) const {}
};

__device__ __forceinline__ unsigned cvt_pk_bf16(float lo, float hi) { unsigned r; asm volatile("v_cvt_pk_bf16_f32 %0, %1, %2" : "=v"(r) : "v"(lo), "v"(hi)); return r; }
typedef float f32x2 __attribute__((ext_vector_type(2)));
__device__ __forceinline__ f32x2 gelu_pk(f32x2 v) {
    const f32x2 av = __builtin_elementwise_abs(v), d = av * 0.2316418882f + 1.0f;
    f32x2 t; t.x = __builtin_amdgcn_rcpf(d.x); t.y = __builtin_amdgcn_rcpf(d.y);
    f32x2 q = t * 0.5307027145f + (-0.7265760135f); q = q * t + 0.7107068705f; q = q * t + (-0.142248368f); q = q * t + 0.127414796f; q = q * t;
    const f32x2 s = (v * v) * (-0.72134752044f);
    f32x2 e; e.x = __builtin_amdgcn_exp2f(s.x); e.y = __builtin_amdgcn_exp2f(s.y);
    const f32x2 m = v * (q * e), r = v - m;
    f32x2 o; o.x = v.x < 0.f ? m.x : r.x; o.y = v.y < 0.f ? m.y : r.y; return o;
}

template <int ACT  > struct EpiBf16 {
    static constexpr bool PERM = true, AFTER_DRAIN = false; static_assert(ACT == 0 || ACT == 1, "EpiBf16: ACT is 0 (none) or 1 (gelu_pk)");
    bf16_t* O; int ldc; const float* bias; int split_cols; size_t split_stride; float scale0;
    __device__ __forceinline__ void operator()(const f32x4 (&acc)[2][2][4][2], const Unit& u, int wr, int wc, int fr, int fq) const {
        const int row0 = u.pm * BM + wr * 64 + fr; int colt = u.pn * BM; bf16_t* base = O;
        float sc = 1.f; if (split_cols) { const int t = colt / split_cols; base += (size_t)t * split_stride; colt -= t * split_cols; if (t == 0) sc = scale0; }
        const int col0 = colt + wc * 32 + 8 * fq, bcol0 = u.pn * BM + wc * 32 + 8 * fq;
        f32x4 bv[2][2];
#pragma unroll
        for (int bj = 0; bj < 2; ++bj)
#pragma unroll
            for (int n = 0; n < 2; ++n) bv[bj][n] = bias ? *(const f32x4*)(bias + bcol0 + bj * HALF + 4 * n) : (f32x4){0.f, 0.f, 0.f, 0.f};
#pragma unroll
        for (int ai = 0; ai < 2; ++ai)
#pragma unroll
            for (int m = 0; m < 4; ++m) { bf16_t* rowp = base + (size_t)(row0 + ai * HALF + m * 16) * ldc + col0;
#pragma unroll
                for (int bj = 0; bj < 2; ++bj) { f32x4 v0 = acc[ai][bj][m][0] + bv[bj][0], v1 = acc[ai][bj][m][1] + bv[bj][1];
                    if (ACT == 1) { f32x2 a = gelu_pk((f32x2){v0[0], v0[1]}), b = gelu_pk((f32x2){v0[2], v0[3]}), c = gelu_pk((f32x2){v1[0], v1[1]}), d = gelu_pk((f32x2){v1[2], v1[3]});
                        v0 = (f32x4){a.x, a.y, b.x, b.y}; v1 = (f32x4){c.x, c.y, d.x, d.y}; }
                    v0 = v0 * sc; v1 = v1 * sc; u32x4 w; w.x = cvt_pk_bf16(v0[0], v0[1]); w.y = cvt_pk_bf16(v0[2], v0[3]); w.z = cvt_pk_bf16(v1[0], v1[1]); w.w = cvt_pk_bf16(v1[2], v1[3]);
                    *(u32x4*)(rowp + bj * HALF) = w; } }
    }
};
template <class Epi, class Sched, bool ALIGN_EPI = false, bool SP2 = false>
__device__ __forceinline__ void gemm_phase(PG8_LAS unsigned char* lds, const Gemm g, const Sched& S, const Epi& E) {
    int tid_ = threadIdx.x; asm volatile("" : "+v"(tid_)); const int tid = tid_, wid = __builtin_amdgcn_readfirstlane(tid >> 6), lane = tid & 63, wr = wid >> 2, wc = wid & 3, fr = lane & 15, fq = lane >> 4;
    const int K = g.K, nt = K / BK;
    unsigned voffA[2], voffB[2];
#pragma unroll
    for (int i = 0; i < 2; ++i) { int R, C; stage_rc(tid * 16 + i * 8192, R, C); const int Rb = Epi::PERM ? ((R & ~31) + perm32(R & 31)) : R;
        voffA[i] = (unsigned)(R * K + C) * 2u; voffB[i] = (unsigned)(Rb * K + C) * 2u; }
    const size_t kstep = (size_t)(BK * 2);
    const size_t hstep = (size_t)HALF * K * 2;
    const size_t tstep = 2 * hstep;
    const unsigned ldsw = (unsigned)wid * 1024u;
    const int aoff = lds_byte(wr * 64 + fr, fq * 8), boff = lds_byte(wc * 32 + fr, fq * 8);
#define PG8_SA(b, h) (((b) * 2 + (h)) * HTB)
#define PG8_SB(b, h) ((4 + (b) * 2 + (h)) * HTB)
#define PG8_STAGE(bufoff, gbase, voff) do { _Pragma("unroll") for (int _i = 0; _i < 2; ++_i) \
        __builtin_amdgcn_global_load_lds((const unsigned*)((const char*)(gbase) + (voff)[_i]), (PG8_LAS unsigned*)(lds + (bufoff) + ldsw + _i * 8192), 16, 0, 0); } while (0)
#define PG8_LDA(dst, b, h) do { _Pragma("unroll") for (int m = 0; m < 4; ++m) _Pragma("unroll") for (int k = 0; k < 2; ++k) dst[m][k] = *(const PG8_LAS bf16x8*)(lds + PG8_SA(b, h) + aoff + m * 2048 + k * 1024); } while (0)
#define PG8_LDB(dst, b, h) do { _Pragma("unroll") for (int n = 0; n < 2; ++n) _Pragma("unroll") for (int k = 0; k < 2; ++k) dst[n][k] = *(const PG8_LAS bf16x8*)(lds + PG8_SB(b, h) + boff + n * 2048 + k * 1024); } while (0)
#define PG8_MMA(ai, bj, At, Bt) do { __builtin_amdgcn_s_setprio(1); _Pragma("unroll") for (int m = 0; m < 4; ++m) _Pragma("unroll") for (int n = 0; n < 2; ++n) _Pragma("unroll") for (int k = 0; k < 2; ++k) \
        acc[ai][bj][m][n] = __builtin_amdgcn_mfma_f32_16x16x32_bf16(Bt[n][k], At[m][k], acc[ai][bj][m][n], 0, 0, 0); __builtin_amdgcn_s_setprio(0); } while (0)
#define PG8_WAIT_V(n) asm volatile("s_waitcnt vmcnt(" #n ")" ::: "memory")
#define PG8_WAIT_L(n) asm volatile("s_waitcnt lgkmcnt(" #n ")" ::: "memory")
#define PG8_BAR __builtin_amdgcn_s_barrier()
#define PG8_SCHED __builtin_amdgcn_sched_barrier(0)
    Unit cur, nxt; int ui = 0;
    if (!S.next(0, cur)) return;
    f32x4 acc[2][2][4][2];
#pragma unroll
    for (int a = 0; a < 2; ++a)
#pragma unroll
        for (int b = 0; b < 2; ++b)
#pragma unroll
            for (int m = 0; m < 4; ++m)
#pragma unroll
                for (int n = 0; n < 2; ++n) acc[a][b][m][n] = (f32x4){0.f, 0.f, 0.f, 0.f};
    bf16x8 At[4][2], B0[2][2], B1[2][2];
    const char* cA = (const char*)g.A + (size_t)cur.pm * tstep; const char* cB = (const char*)g.Bt + (size_t)cur.pn * tstep;
    S.a_ready(cur);
    if constexpr (SP2) {
        PG8_STAGE(PG8_SB(0, 0), cB, voffB); PG8_STAGE(PG8_SB(0, 1), cB + hstep, voffB); PG8_STAGE(PG8_SA(0, 0), cA, voffA); PG8_STAGE(PG8_SA(0, 1), cA + hstep, voffA);
        if (wr == 1) PG8_BAR;
        PG8_WAIT_V(2); PG8_BAR;
        PG8_STAGE(PG8_SB(1, 0), cB + kstep, voffB); PG8_STAGE(PG8_SA(1, 0), cA + kstep, voffA); PG8_STAGE(PG8_SB(1, 1), cB + hstep + kstep, voffB);
        PG8_WAIT_V(6); PG8_BAR;
    } else {
        PG8_STAGE(PG8_SB(0, 0), cB, voffB); PG8_STAGE(PG8_SA(0, 0), cA, voffA); PG8_STAGE(PG8_SB(0, 1), cB + hstep, voffB); PG8_STAGE(PG8_SA(0, 1), cA + hstep, voffA);
        if (wr == 1) PG8_BAR;
        PG8_WAIT_V(4); PG8_BAR;
        PG8_STAGE(PG8_SB(1, 0), cB + kstep, voffB); PG8_STAGE(PG8_SA(1, 0), cA + kstep, voffA); PG8_STAGE(PG8_SB(1, 1), cB + hstep + kstep, voffB);
        PG8_WAIT_V(6); PG8_BAR;
    }
    for (;;) {
        const bool has_next = S.next(ui + 1, nxt);
        const char* nA = has_next ? (const char*)g.A + (size_t)nxt.pm * tstep : cA; const char* nB = has_next ? (const char*)g.Bt + (size_t)nxt.pn * tstep : cB;
        for (int t = 0; t < nt; t += 2) {
            const bool last = (t == nt - 2);
            const char* a1 = cA + (size_t)(t + 1) * kstep;
            const char* a2 = last ? nA : cA + (size_t)(t + 2) * kstep; const char* b2 = last ? nB : cB + (size_t)(t + 2) * kstep;
            const char* a3 = a2 + kstep; const char* b3 = b2 + kstep;
            if (last && has_next) S.a_ready(nxt);
            if constexpr (SP2) {
            PG8_LDB(B0, 0, 0); PG8_LDB(B1, 0, 1); PG8_SCHED; PG8_LDA(At, 0, 0); PG8_STAGE(PG8_SA(1, 1), a1 + hstep, voffA);
            PG8_WAIT_V(8); PG8_WAIT_L(0); PG8_BAR; PG8_MMA(0, 0, At, B0); PG8_MMA(0, 1, At, B1); PG8_BAR; PG8_SCHED;
            PG8_LDA(At, 0, 1); PG8_STAGE(PG8_SB(0, 0), b2, voffB); PG8_STAGE(PG8_SB(0, 1), b2 + hstep, voffB); PG8_STAGE(PG8_SA(0, 0), a2, voffA);
            PG8_WAIT_V(8); PG8_WAIT_L(0); PG8_BAR; PG8_MMA(1, 0, At, B0); PG8_MMA(1, 1, At, B1); PG8_BAR; PG8_SCHED;
            PG8_LDB(B0, 1, 0); PG8_LDB(B1, 1, 1); PG8_SCHED; PG8_LDA(At, 1, 0); PG8_STAGE(PG8_SA(0, 1), a2 + hstep, voffA);
            PG8_WAIT_V(8); PG8_WAIT_L(0); PG8_BAR; PG8_MMA(0, 0, At, B0); PG8_MMA(0, 1, At, B1); PG8_BAR; PG8_SCHED;
            PG8_LDA(At, 1, 1); PG8_STAGE(PG8_SB(1, 0), b3, voffB); PG8_STAGE(PG8_SB(1, 1), b3 + hstep, voffB); PG8_STAGE(PG8_SA(1, 0), a3, voffA);
            PG8_WAIT_V(8); PG8_WAIT_L(0); PG8_BAR; PG8_MMA(1, 0, At, B0); PG8_MMA(1, 1, At, B1); PG8_BAR; PG8_SCHED;
            } else {
            PG8_LDB(B0, 0, 0); PG8_SCHED; PG8_LDA(At, 0, 0); PG8_STAGE(PG8_SA(1, 1), a1 + hstep, voffA);
            PG8_WAIT_L(8); PG8_BAR; PG8_WAIT_L(0); PG8_MMA(0, 0, At, B0); PG8_BAR; PG8_SCHED;
            PG8_LDB(B1, 0, 1); PG8_STAGE(PG8_SB(0, 0), b2, voffB);
            PG8_BAR; PG8_WAIT_L(0); PG8_MMA(0, 1, At, B1); PG8_BAR;
            PG8_LDA(At, 0, 1); PG8_STAGE(PG8_SA(0, 0), a2, voffA);
            PG8_BAR; PG8_WAIT_L(0); PG8_MMA(1, 0, At, B0); PG8_BAR; PG8_SCHED;
            PG8_STAGE(PG8_SB(0, 1), b2 + hstep, voffB);
            PG8_WAIT_V(6); PG8_BAR; PG8_MMA(1, 1, At, B1); PG8_BAR;
            PG8_LDB(B0, 1, 0); PG8_SCHED; PG8_LDA(At, 1, 0); PG8_STAGE(PG8_SA(0, 1), a2 + hstep, voffA);
            PG8_WAIT_L(8); PG8_BAR; PG8_WAIT_L(0); PG8_MMA(0, 0, At, B0); PG8_BAR; PG8_SCHED;
            PG8_LDB(B1, 1, 1); PG8_STAGE(PG8_SB(1, 0), b3, voffB);
            PG8_BAR; PG8_WAIT_L(0); PG8_MMA(0, 1, At, B1); PG8_BAR;
            PG8_LDA(At, 1, 1); PG8_STAGE(PG8_SA(1, 0), a3, voffA);
            PG8_BAR; PG8_WAIT_L(0); PG8_MMA(1, 0, At, B0); PG8_BAR; PG8_SCHED;
            PG8_STAGE(PG8_SB(1, 1), b3 + hstep, voffB);
            PG8_WAIT_V(6); PG8_BAR; PG8_MMA(1, 1, At, B1); PG8_BAR;
            }
        }
        if constexpr (ALIGN_EPI) { if (wr == 0) PG8_BAR; }
        if constexpr (!Epi::AFTER_DRAIN) { E(acc, cur, wr, wc, fr, fq); S.done(cur); }
        if (!has_next) break;
#pragma unroll
        for (int a = 0; a < 2; ++a)
#pragma unroll
            for (int b = 0; b < 2; ++b)
#pragma unroll
                for (int m = 0; m < 4; ++m)
#pragma unroll
                    for (int n = 0; n < 2; ++n) acc[a][b][m][n] = (f32x4){0.f, 0.f, 0.f, 0.f};
        cur = nxt; cA = nA; cB = nB; ++ui;
        if constexpr (ALIGN_EPI) { if (wr == 1) PG8_BAR; }
    }
    PG8_WAIT_V(0);
    if constexpr (!ALIGN_EPI) { if (wr == 0) PG8_BAR; }
    PG8_BAR;
    if constexpr (Epi::AFTER_DRAIN) { E.fused(acc, cur, wr, wc, fr, fq, lds, wid, lane); S.done(cur); }
#undef PG8_SA
#undef PG8_SB
#undef PG8_STAGE
#undef PG8_LDA
#undef PG8_LDB
#undef PG8_MMA
#undef PG8_WAIT_V
#undef PG8_WAIT_L
#undef PG8_BAR
#undef PG8_SCHED
}
}
constexpr int D = 1024, M = 12288, NCTX = 8192, DFF = 2816, DEPTH = 4;
constexpr int NWAVES = 8, NTHREADS = 512;
constexpr float ALPHA = 1.681792830507429f;
constexpr float EPS = 1e-6f;
constexpr int NA_IN = 2304;
constexpr int HQ_K = 256, HQ_V = 512, HQ_R = 1024, HQ_PZ = 1536, HQ_LR = 2048;
constexpr size_t OUT_Y = 0, OUT_GLA = 12582912, OUT_DN = 16777216;

constexpr size_t MiB = 1u << 20;
constexpr size_t WS_CTL = 0, CTL_ZERO_BYTES = 1 * MiB;
constexpr size_t WS_MOD = 256 * 1024;
constexpr size_t WS_WA_IN = 1 * MiB;
constexpr size_t WS_WA_OUT = 10 * MiB;
constexpr size_t WS_WC_IN = 14 * MiB;
constexpr size_t WC_IN_STRIDE = 4128ull * 1024 * 2;
constexpr size_t WS_WC_OUT = 31 * MiB;
constexpr size_t WS_WUP = 35 * MiB;
constexpr size_t WS_WDOWN = 79 * MiB;
constexpr size_t WS_WPOOL = 101 * MiB;
constexpr size_t WS_U = 104 * MiB;
constexpr size_t WS_BIG = 128 * MiB;
constexpr size_t WS_HQ = WS_BIG;
constexpr size_t WS_GLAU = WS_BIG + 64 * MiB;
constexpr size_t WS_GLAD = WS_BIG + 112 * MiB;
constexpr size_t WS_QKVZ = WS_BIG;
constexpr size_t QKVZ_STRIDE = (size_t)M * 1024;
constexpr size_t WS_AB = WS_BIG + 96 * MiB;
constexpr size_t WS_BCUM = WS_BIG + 98 * MiB;
constexpr size_t WS_QN = WS_BIG + 100 * MiB, WS_KN = WS_BIG + 124 * MiB;
constexpr size_t WS_UT = WS_BIG + 148 * MiB;
constexpr size_t WS_WN = WS_BIG + 196 * MiB;
constexpr size_t WS_AQK = WS_BIG + 244 * MiB;
constexpr size_t WS_OF = WS_BIG + 268 * MiB, WS_OB = WS_BIG + 292 * MiB;
constexpr size_t WS_AOP1 = WS_BIG + 316 * MiB;
constexpr size_t WS_V = WS_BIG + 336 * MiB;
constexpr size_t WS_H = WS_BIG;
constexpr size_t WS_AOP2 = WS_BIG + 132 * MiB;
constexpr size_t WS_END = 512 * MiB;
constexpr int CW_BAR = 4096;

constexpr int LDS_BYTES = 147456;
constexpr int LDSCTL_OFF = 146944;
constexpr int PH_LDS = 146944;

#define GAS __attribute__((address_space(1)))
#define LAS __attribute__((address_space(3)))
typedef unsigned short bf16;
typedef unsigned v4u __attribute__((ext_vector_type(4)));
typedef unsigned v2u __attribute__((ext_vector_type(2)));
typedef float f32x4 __attribute__((ext_vector_type(4)));
typedef float f32x2 __attribute__((ext_vector_type(2)));
typedef short bf16x8 __attribute__((ext_vector_type(8)));
typedef short bf16x4 __attribute__((ext_vector_type(4)));
typedef GAS unsigned gu32;
#define RLX_AGENT __ATOMIC_RELAXED, __HIP_MEMORY_SCOPE_AGENT
#define LDS_WAIT() asm volatile("s_waitcnt lgkmcnt(0)" ::: "memory")
#define VM_WAIT() asm volatile("s_waitcnt vmcnt(0)" ::: "memory")
__device__ __forceinline__ unsigned f2bf(float f) { unsigned u = __builtin_bit_cast(unsigned, f); return (u + 0x7fffu + ((u >> 16) & 1u)) >> 16; }
__device__ __forceinline__ unsigned pk2(float lo, float hi) { return pg8::cvt_pk_bf16(lo, hi); }
__device__ __forceinline__ float bf2f(unsigned b) { return __builtin_bit_cast(float, b << 16); }
__device__ __forceinline__ float bflo(unsigned w) { return __builtin_bit_cast(float, w << 16); }
__device__ __forceinline__ float bfhi(unsigned w) { return __builtin_bit_cast(float, w & 0xffff0000u); }
__device__ __forceinline__ float siluf(float x) { return x / (1.f + __expf(-x)); }
__device__ __forceinline__ float sigmoidf_(float x) { return 1.f / (1.f + __expf(-x)); }
__device__ __forceinline__ float softplusf_(float x) { return fmaxf(x, 0.f) + log1pf(__expf(-fabsf(x))); }
__device__ __forceinline__ float logsigmoidf_(float x) { return fminf(x, 0.f) - log1pf(__expf(-fabsf(x))); }
__device__ __forceinline__ f32x4 mfma16(bf16x8 a, bf16x8 b, f32x4 c) { return __builtin_amdgcn_mfma_f32_16x16x32_bf16(a, b, c, 0, 0, 0); }
__device__ __forceinline__ bf16x8 acc2frag(f32x4 a, f32x4 b) { v4u v; v.x = pk2(a[0], a[1]); v.y = pk2(a[2], a[3]); v.z = pk2(b[0], b[1]); v.w = pk2(b[2], b[3]); return __builtin_bit_cast(bf16x8, v); }
__device__ __forceinline__ bf16x8 ldsfrag(const LAS bf16* tile, int row, int stride, int k) { return *(const LAS bf16x8*)(tile + row * stride + k); }
__device__ __forceinline__ bf16x8 ldsfrag_perm(const LAS bf16* tile, int row, int stride, int k0, int h) {
    const bf16x4 lo = *(const LAS bf16x4*)(tile + row * stride + k0 + 4 * h), hi = *(const LAS bf16x4*)(tile + row * stride + k0 + 16 + 4 * h);
    return __builtin_shufflevector(lo, hi, 0, 1, 2, 3, 4, 5, 6, 7);
}
__device__ __forceinline__ float opaque_zero() { float z = 0.f; asm volatile("" : "+v"(z)); return z; }
__device__ __forceinline__ float wave_sum(float v) {
#pragma unroll
    for (int o = 1; o < 64; o <<= 1) v += __shfl_xor(v, o);
    return v;
}
__device__ __forceinline__ int row_cond(int row) { return row < NCTX ? 0 : 1 + ((row - NCTX) >> 11); }
__device__ __forceinline__ void chunk_geom(int cg, int& seq_start, int& seq_len) { if (cg < 128) { seq_start = (cg >> 2) << 8; seq_len = 256; } else { seq_start = NCTX + (((cg - 128) >> 5) << 11); seq_len = 2048; } }

#define XB_TMO      128
#define XB_XCNT(j)  (256  + 64 * (j))
#define XB_XSUB(j)  (1280 + 64 * (j))
#define XB_XGEN(j)  (2304 + 64 * (j))
#define XB_TOP      3328
#define XB_TOPGEN   3392
#define XCD_BAR_WORDS 3456
#define XB_SPIN_CAP (1u << 20)
__device__ __forceinline__ unsigned xb_ld(unsigned* p)              { return __hip_atomic_load(p, __ATOMIC_RELAXED, __HIP_MEMORY_SCOPE_AGENT); }
__device__ __forceinline__ unsigned xb_add(unsigned* p, unsigned v) { return __hip_atomic_fetch_add(p, v, __ATOMIC_RELAXED, __HIP_MEMORY_SCOPE_AGENT); }
__device__ __forceinline__ unsigned xb_xcc_id() { return (unsigned)__builtin_amdgcn_s_getreg((3 << 11) | 20) & 0xFu; }
#define XB_SPIN(cond, bar) do { unsigned _sp = 0; while (cond) { __builtin_amdgcn_s_sleep(1); \
    if ((++_sp & 255u) == 0u) { if (xb_ld(&(bar)[XB_TMO])) break; if (_sp > XB_SPIN_CAP) { atomicAdd(&(bar)[XB_TMO], 1u); break; } } } } while (0)
struct XcdBarrier { unsigned* bar; unsigned x; volatile LAS unsigned* st; };
__device__ __forceinline__ XcdBarrier xcd_barrier_post(unsigned* bar, volatile LAS unsigned* st) {
    XcdBarrier b; b.bar = bar; b.x = xb_xcc_id(); b.st = st;
    if (threadIdx.x == 0) (void)xb_add(&bar[XB_XCNT(b.x)], 1u);
    return b;
}
__device__ __forceinline__ void xcd_barrier_complete(unsigned* bar, unsigned x, unsigned& nloc, unsigned& nx) {
    const unsigned G = gridDim.x * gridDim.y * gridDim.z;
    unsigned sum, cnt, mine, sp = 0u;
    for (;;) {
        sum = 0u; cnt = 0u; mine = 0u;
#pragma unroll
        for (unsigned j = 0; j < 16; ++j) { const unsigned c = xb_ld(&bar[XB_XCNT(j)]); sum += c; cnt += (c > 0u) ? 1u : 0u; mine = (j == x) ? c : mine; }
        if (sum == G) break;
        __builtin_amdgcn_s_sleep(1);
        if ((++sp & 255u) == 0u) { if (xb_ld(&bar[XB_TMO])) break; if (sp > XB_SPIN_CAP) { atomicAdd(&bar[XB_TMO], 1u); break; } }
    }
    nloc = mine > 0u ? mine : 1u; nx = cnt > 0u ? cnt : 1u;
}
__device__ __forceinline__ void xcd_barrier(const XcdBarrier& b) {
    asm volatile("s_waitcnt vmcnt(0)" ::: "memory");
    __syncthreads();
    if (threadIdx.x == 0) {
        unsigned* bar = b.bar;
        __builtin_amdgcn_s_waitcnt(0);
        unsigned nloc = b.st[0], nx = b.st[1];
        if (nloc == 0u) { xcd_barrier_complete(bar, b.x, nloc, nx); b.st[0] = nloc; b.st[1] = nx; }
        const unsigned old = xb_add(&bar[XB_XSUB(b.x)], 1u);
        const unsigned gen = old / nloc;
        if (old + 1u == (gen + 1u) * nloc) {
            __builtin_amdgcn_fence(__ATOMIC_RELEASE, "agent");
            asm volatile("s_waitcnt vmcnt(0)" ::: "memory");
            const unsigned og = xb_add(&bar[XB_TOP], 1u);
            const unsigned tg = og / nx;
            if (og + 1u == (tg + 1u) * nx) xb_add(&bar[XB_TOPGEN], 1u);
            else XB_SPIN(xb_ld(&bar[XB_TOPGEN]) == tg, bar);
            __builtin_amdgcn_fence(__ATOMIC_ACQUIRE, "agent");
            xb_add(&bar[XB_XGEN(b.x)], 1u);
            asm volatile("s_waitcnt vmcnt(0)" ::: "memory");
        } else {
            XB_SPIN(xb_ld(&bar[XB_XGEN(b.x)]) == gen, bar);
            __builtin_amdgcn_fence(__ATOMIC_ACQUIRE, "agent");
            asm volatile("s_waitcnt vmcnt(0)" ::: "memory");
        }
    }
    __syncthreads();
}

struct Frame {
    LAS unsigned char* lds;
    int tid, lane, wave;
    int G, gw, NGW;
    float* out;
    unsigned char* ws;
};
constexpr int INTAB_OFF = LDSCTL_OFF + 64;
__device__ __forceinline__ const float* inp(const Frame& F, int k) {
    const LAS unsigned* t = (const LAS unsigned*)(F.lds + INTAB_OFF) + 2 * k;
    const unsigned lo = __builtin_amdgcn_readfirstlane(t[0]), hi = __builtin_amdgcn_readfirstlane(t[1]);
    const GAS float* g = (const GAS float*)(((unsigned long long)hi << 32) | lo);
    return (const float*)g;
}
__device__ __forceinline__ void frame_refresh(Frame& F) {
    int t = threadIdx.x; asm volatile("" : "+v"(t));
    F.tid = t; F.lane = t & 63; F.wave = __builtin_amdgcn_readfirstlane(t >> 6);
    int b = blockIdx.x; asm volatile("" : "+s"(b));
    F.gw = b * NWAVES + F.wave;
}
__device__ __forceinline__ void p0_transpose_item(const float* W, int K, int N, bf16* WT, int k0, int n0, int dst_row0, LAS float* scr, int lane) {
#pragma unroll 8
    for (int i = 0; i < 32; ++i) { const int kk = 2 * i + (lane >> 5); scr[kk * 33 + (lane & 31)] = W[(size_t)(k0 + kk) * N + n0 + (lane & 31)]; }
    LDS_WAIT(); asm volatile("" ::: "memory");
    const int c = lane & 7;
#pragma unroll
    for (int j = 0; j < 4; ++j) { const int n = (lane >> 3) + 8 * j; const LAS float* s = scr + (8 * c) * 33 + n;
        v4u o; o.x = pk2(s[0 * 33], s[1 * 33]); o.y = pk2(s[2 * 33], s[3 * 33]); o.z = pk2(s[4 * 33], s[5 * 33]); o.w = pk2(s[6 * 33], s[7 * 33]);
        *(GAS v4u*)(WT + (size_t)(dst_row0 + n) * K + k0 + 8 * c) = o; }
    LDS_WAIT(); asm volatile("" ::: "memory");
}
__device__ __forceinline__ int a_in_rowmap(int n0) { return n0 < 1536 ? n0 : (n0 < 1568 ? 2048 + (n0 - 1536) : n0 - 32); }

__device__ __forceinline__ void p0_prologue(Frame& F) {
    LAS float* scr = (LAS float*)(F.lds + F.wave * 16384);
    const int gw = F.gw, NGW = F.NGW, lane = F.lane;
    unsigned char* ws = F.ws;
    constexpr int I0 = 2 * 16 * 65, I1 = 2 * 16 * 32, I2 = 2 * 16 * 129, I3 = I1, I4 = 4 * 16 * 176, I5 = 4 * 44 * 32, I6 = 8 * 8;
    constexpr int NITEMS = I0 + I1 + I2 + I3 + I4 + I5 + I6;
    for (int it = gw; it < NITEMS; it += NGW) {
        int r = it;
        if (r < I0) { const int e = r / 1040, q = r % 1040, kb = q / 65, nb = q % 65;
            p0_transpose_item(inp(F, 12) + (size_t)e * 1024 * 2080, 1024, 2080, (bf16*)(ws + WS_WA_IN) + (size_t)e * NA_IN * 1024, 64 * kb, 32 * nb, a_in_rowmap(32 * nb), scr, lane); continue; } r -= I0;
        if (r < I1) { const int e = r / 512, q = r % 512, kb = q / 32, nb = q % 32;
            p0_transpose_item(inp(F, 18) + (size_t)e * 1024 * 1024, 1024, 1024, (bf16*)(ws + WS_WA_OUT) + (size_t)e * 1024 * 1024, 64 * kb, 32 * nb, 32 * nb, scr, lane); continue; } r -= I1;
        if (r < I2) { const int o = r / 2064, q = r % 2064, kb = q / 129, nb = q % 129;
            p0_transpose_item(inp(F, 19) + (size_t)o * 1024 * 4128, 1024, 4128, (bf16*)(ws + WS_WC_IN + o * WC_IN_STRIDE), 64 * kb, 32 * nb, 32 * nb, scr, lane); continue; } r -= I2;
        if (r < I3) { const int o = r / 512, q = r % 512, kb = q / 32, nb = q % 32;
            p0_transpose_item(inp(F, 24) + (size_t)o * 1024 * 1024, 1024, 1024, (bf16*)(ws + WS_WC_OUT) + (size_t)o * 1024 * 1024, 64 * kb, 32 * nb, 32 * nb, scr, lane); continue; } r -= I3;
        if (r < I4) { const int l = r / 2816, q = r % 2816, kb = q / 176, nb = q % 176;
            p0_transpose_item(inp(F, 25) + (size_t)l * 1024 * 5632, 1024, 5632, (bf16*)(ws + WS_WUP) + (size_t)l * 5632 * 1024, 64 * kb, 32 * nb, 32 * nb, scr, lane); continue; } r -= I4;
        if (r < I5) { const int l = r / 1408, q = r % 1408, kb = q / 32, nb = q % 32;
            p0_transpose_item(inp(F, 27) + (size_t)l * 2816 * 1024, 2816, 1024, (bf16*)(ws + WS_WDOWN) + (size_t)l * 1024 * 2816, 64 * kb, 32 * nb, 32 * nb, scr, lane); continue; } r -= I5;
        { const int eg = r / 8, q = r % 8, kb = q / 4, nb = q % 4;
            p0_transpose_item(inp(F, 16) + (size_t)eg * 128 * 128, 128, 128, (bf16*)(ws + WS_WPOOL) + (size_t)eg * 128 * 128, 64 * kb, 32 * nb, 32 * nb, scr, lane); }
    }
    for (int i = gw * 64 + lane; i < 2 * 224 * 128; i += NGW * 64) { const int e = i / (224 * 128), q = i % (224 * 128);
        *(GAS v4u*)((bf16*)(ws + WS_WA_IN) + (size_t)e * NA_IN * 1024 + (size_t)2080 * 1024 + (size_t)q * 8) = (v4u){0u, 0u, 0u, 0u}; }
    {
        float* MOD = (float*)(ws + WS_MOD);
        for (int u = gw; u < 4 * 8 * 24; u += NGW) {
            const int l = u / 192, q = u % 192, kb = q / 24, nb = q % 24;
#pragma unroll
            for (int c = 0; c < 3; ++c)
#pragma unroll
                for (int j = 0; j < 2; ++j) { const int k = kb * 128 + lane + 64 * j; const float v = (c == 0) ? inp(F, 5)[k] : inp(F, 4)[(c - 1) * 1024 + k]; scr[c * 128 + lane + 64 * j] = siluf(v); }
            LDS_WAIT(); asm volatile("" ::: "memory");
            const float* wp = inp(F, 6) + ((size_t)l * 1024 + kb * 128) * 6144 + nb * 256 + 4 * lane;
            f32x4 a0 = {0.f, 0.f, 0.f, 0.f}, a1 = a0, a2 = a0;
#pragma unroll 8
            for (int k = 0; k < 128; ++k) { const f32x4 w = *(const GAS f32x4*)(wp + (size_t)k * 6144); const float s0 = scr[k], s1 = scr[128 + k], s2 = scr[256 + k];
                a0 += w * s0; a1 += w * s1; a2 += w * s2; }
            if (kb == 0) { const f32x4 b = *(const GAS f32x4*)(inp(F, 7) + (size_t)l * 6144 + nb * 256 + 4 * lane); a0 += b; a1 += b; a2 += b; }
            float* mp = MOD + (size_t)l * 3 * 6144 + nb * 256 + 4 * lane;
#pragma unroll
            for (int j = 0; j < 4; ++j) { __hip_atomic_fetch_add(mp + j, a0[j], RLX_AGENT); __hip_atomic_fetch_add(mp + 6144 + j, a1[j], RLX_AGENT); __hip_atomic_fetch_add(mp + 2 * 6144 + j, a2[j], RLX_AGENT); }
            LDS_WAIT(); asm volatile("" ::: "memory");
        }
    }
    for (int m = gw; m < M; m += NGW) {
        GAS f32x4* o = (GAS f32x4*)(F.out + (size_t)m * D) + lane;
        if (m < NCTX) { const GAS f32x4* xr = (const GAS f32x4*)(inp(F, 0) + (size_t)m * D) + lane;
#pragma unroll
            for (int j = 0; j < 4; ++j) o[64 * j] = xr[64 * j];
        } else {
            const int ms = m - NCTX; const GAS f32x4* xr = (const GAS f32x4*)(inp(F, 1) + (size_t)ms * D) + lane;
            const int t = ms & 2047; const float rr = (float)(t >> 6), cc = (float)(t & 63);
            float fr[4];
#pragma unroll
            for (int e = 0; e < 4; ++e) fr[e] = expf(-9.210340371976184f * (float)(4 * lane + e) * (1.f / 256.f));
#pragma unroll
            for (int j = 0; j < 4; ++j) { f32x4 v = xr[64 * j];
#pragma unroll
                for (int e = 0; e < 4; ++e) { const float a = ((j < 2) ? rr : cc) * fr[e];
                    const float kq = rintf(a * 0.15915494309189535f); float r = fmaf(-kq, 6.28125f, a); r = fmaf(-kq, 1.9353071795864769e-3f, r);
                    v[e] += (j & 1) ? __cosf(r) : __sinf(r); }
                o[64 * j] = v; }
        }
    }
}

template <bool DO_LN, bool DO_MOD>
__device__ __forceinline__ void rows_ln_mod(Frame& F, const float* src, const float* ln_g, const float* ln_b, float* Xout, const float* msc, const float* msh, bf16* U) {
    const int lane = F.lane;
    for (int m = F.gw; m < M; m += F.NGW) {
        const GAS f32x4* xr = (const GAS f32x4*)(src + (size_t)m * D) + lane;
        f32x4 v[4];
#pragma unroll
        for (int j = 0; j < 4; ++j) v[j] = xr[64 * j];
        if (DO_LN) {
            float s = 0.f;
#pragma unroll
            for (int j = 0; j < 4; ++j) s += (v[j].x + v[j].y) + (v[j].z + v[j].w);
            const float mean = wave_sum(s) * (1.f / D); float s2 = 0.f;
#pragma unroll
            for (int j = 0; j < 4; ++j) { v[j] = v[j] - mean; s2 += (v[j].x * v[j].x + v[j].y * v[j].y) + (v[j].z * v[j].z + v[j].w * v[j].w); }
            const float rstd = 1.f / sqrtf(wave_sum(s2) * (1.f / D) + EPS);
            GAS f32x4* xo = (GAS f32x4*)(Xout + (size_t)m * D) + lane;
#pragma unroll
            for (int j = 0; j < 4; ++j) { const f32x4 g = *((const GAS f32x4*)ln_g + lane + 64 * j), b = *((const GAS f32x4*)ln_b + lane + 64 * j); v[j] = v[j] * rstd * g + b; xo[64 * j] = v[j]; }
        }
        if (DO_MOD) {
            const int c = row_cond(m);
            const GAS f32x4* sc = (const GAS f32x4*)(msc + (size_t)c * 6144) + lane; const GAS f32x4* sh = (const GAS f32x4*)(msh + (size_t)c * 6144) + lane;
            GAS v2u* o8 = (GAS v2u*)(U + (size_t)m * D) + lane;
#pragma unroll
            for (int j = 0; j < 4; ++j) { const f32x4 a = sc[64 * j], b = sh[64 * j]; const f32x4 u = v[j] * (a + 1.f) + b; v2u w; w.x = pk2(u.x, u.y); w.y = pk2(u.z, u.w); o8[64 * j] = w; }
        }
    }
}

__device__ __forceinline__ void conv_gate_phase(Frame& F, const bf16* H, const float* cw  , bf16* O) {
    const int lane = F.lane;
    for (int it = F.gw; it < 384 * 11; it += F.NGW) {
        const int rb = it / 11, cb = it % 11, r0 = rb * 32, c0 = cb * 256 + 4 * lane;
        int ss, sl; { const int cg = r0 >> 6; chunk_geom(cg, ss, sl); }
        f32x4 wa[3], wg[3];
#pragma unroll
        for (int i = 0; i < 3; ++i) { wa[i] = *(const GAS f32x4*)(cw + (size_t)i * 5632 + c0); wg[i] = *(const GAS f32x4*)(cw + (size_t)i * 5632 + 2816 + c0); }
        f32x4 pa, pg, ca, cg_, na, ng;
        auto ld = [&](int r, f32x4& a, f32x4& g) {
            if (r < ss || r >= ss + sl) { a = (f32x4){0.f, 0.f, 0.f, 0.f}; g = a; return; }
            const v2u x = *(const GAS v2u*)(H + (size_t)r * 5632 + c0), y = *(const GAS v2u*)(H + (size_t)r * 5632 + 2816 + c0);
            a = (f32x4){bflo(x.x), bfhi(x.x), bflo(x.y), bfhi(x.y)}; g = (f32x4){bflo(y.x), bfhi(y.x), bflo(y.y), bfhi(y.y)}; };
        ld(r0 - 1, pa, pg); ld(r0, ca, cg_);
#pragma unroll 4
        for (int i = 0; i < 32; ++i) {
            ld(r0 + i + 1, na, ng);
            const f32x4 a = wa[0] * pa + wa[1] * ca + wa[2] * na, g = wg[0] * pg + wg[1] * cg_ + wg[2] * ng;
            v2u w; w.x = pk2(siluf(g.x) * a.x, siluf(g.y) * a.y); w.y = pk2(siluf(g.z) * a.z, siluf(g.w) * a.w);
            *(GAS v2u*)(O + (size_t)(r0 + i) * 2816 + c0) = w;
            pa = ca; pg = cg_; ca = na; cg_ = ng;
        }
    }
}

struct EpiRes {
    static constexpr bool PERM = false, AFTER_DRAIN = false;
    const float* X; float* V; const float* gate;
    __device__ __forceinline__ void operator()(const f32x4 (&acc)[2][2][4][2], const pg8::Unit& u, int wr, int wc, int fr, int fq) const {
        const int row0 = u.pm * 256 + wr * 64 + fr, col0 = u.pn * 256 + wc * 32 + 4 * fq;
        const int c = u.pm < 32 ? 0 : 1 + ((u.pm - 32) >> 3);
        const float* gp = gate + (size_t)c * 6144;
        f32x4 gv[2][2];
#pragma unroll
        for (int bj = 0; bj < 2; ++bj)
#pragma unroll
            for (int n = 0; n < 2; ++n) gv[bj][n] = *(const f32x4*)(gp + col0 + bj * 128 + n * 16);
#pragma unroll
        for (int ai = 0; ai < 2; ++ai)
#pragma unroll
            for (int m = 0; m < 4; ++m) { const size_t off = (size_t)(row0 + ai * 128 + m * 16) * D + col0;
#pragma unroll
                for (int bj = 0; bj < 2; ++bj)
#pragma unroll
                    for (int n = 0; n < 2; ++n) { const f32x4 x = *(const f32x4*)(X + off + bj * 128 + n * 16); *(f32x4*)(V + off + bj * 128 + n * 16) = x * ALPHA + gv[bj][n] * acc[ai][bj][m][n]; } }
    }
};

__device__ __forceinline__ void skinny_gemm(Frame& F, const bf16* U, const bf16* Wsk, float* AB) {
    const int lane = F.lane, w = F.wave, fr = lane & 15, fq = lane >> 4;
    LAS f32x4* red = (LAS f32x4*)F.lds;
    for (int rb = blockIdx.x; rb < M / 48; rb += F.G) {
        const int row0 = rb * 48;
        f32x4 acc[3][2];
#pragma unroll
        for (int m = 0; m < 3; ++m) { acc[m][0] = (f32x4){0.f, 0.f, 0.f, 0.f}; acc[m][1] = acc[m][0]; }
#pragma unroll
        for (int ks = 0; ks < 4; ++ks) {
            const int k = w * 128 + ks * 32 + 8 * fq;
            bf16x8 a[3], b[2];
#pragma unroll
            for (int m = 0; m < 3; ++m) a[m] = *(const GAS bf16x8*)(U + (size_t)(row0 + 16 * m + fr) * D + k);
#pragma unroll
            for (int n = 0; n < 2; ++n) b[n] = *(const GAS bf16x8*)(Wsk + (size_t)(16 * n + fr) * D + k);
#pragma unroll
            for (int m = 0; m < 3; ++m)
#pragma unroll
                for (int n = 0; n < 2; ++n) acc[m][n] = mfma16(a[m], b[n], acc[m][n]);
        }
#pragma unroll
        for (int m = 0; m < 3; ++m)
#pragma unroll
            for (int n = 0; n < 2; ++n) red[(w * 6 + m * 2 + n) * 64 + lane] = acc[m][n];
        __syncthreads();
        for (int idx = F.tid; idx < 48 * 32; idx += NTHREADS) {
            const int row = idx >> 5, col = idx & 31, m = row >> 4, ri = row & 15, n = col >> 4, l = (ri >> 2) * 16 + (col & 15), r = ri & 3;
            float s = 0.f;
#pragma unroll
            for (int ww = 0; ww < 8; ++ww) s += ((const LAS float*)&red[(ww * 6 + m * 2 + n) * 64 + l])[r];
            AB[(size_t)(row0 + row) * 32 + col] = s;
        }
        __syncthreads();
    }
}
constexpr int GL_OFF = 0, WG_OFF = 32768, GT0 = 40960;
__device__ __forceinline__ void gla_gates(Frame& F, int e, int cg, int h, const bf16* HQ) {
    LAS float* gl = (LAS float*)(F.lds + GL_OFF); LAS float* wg = (LAS float*)(F.lds + WG_OFF);
    const int tid = F.tid, r0 = cg * 64;
    { const int idx = tid * 4, z = idx >> 10, r = (idx >> 6) & 15, ch = idx & 63;
      *(LAS f32x4*)(wg + idx) = *(const GAS f32x4*)(inp(F, 13) + ((size_t)((e * 2 + z) * 16 + r)) * 256 + 64 * h + ch); }
    const int tok = tid >> 3, sub = tid & 7, dir = sub >> 2, chb = (sub & 3) * 16;
    float lr[16];
    { const bf16* p = HQ + (size_t)(r0 + tok) * NA_IN + HQ_LR + 16 * dir; const v4u a = *(const GAS v4u*)p, b = *(const GAS v4u*)(p + 8);
      lr[0] = bflo(a.x); lr[1] = bfhi(a.x); lr[2] = bflo(a.y); lr[3] = bfhi(a.y); lr[4] = bflo(a.z); lr[5] = bfhi(a.z); lr[6] = bflo(a.w); lr[7] = bfhi(a.w);
      lr[8] = bflo(b.x); lr[9] = bfhi(b.x); lr[10] = bflo(b.y); lr[11] = bfhi(b.y); lr[12] = bflo(b.z); lr[13] = bfhi(b.z); lr[14] = bflo(b.w); lr[15] = bfhi(b.w); }
    f32x4 acc[4];
#pragma unroll
    for (int q = 0; q < 4; ++q) acc[q] = *(const GAS f32x4*)(inp(F, 14) + (size_t)(e * 2 + dir) * 256 + 64 * h + chb + 4 * q);
    __syncthreads();
#pragma unroll
    for (int r = 0; r < 16; ++r)
#pragma unroll
        for (int q = 0; q < 4; ++q) acc[q] += *(const LAS f32x4*)(wg + (dir * 16 + r) * 64 + chb + 4 * q) * lr[r];
#pragma unroll
    for (int q = 0; q < 4; ++q) { f32x4 g; g.x = logsigmoidf_(acc[q].x) * 0.0625f; g.y = logsigmoidf_(acc[q].y) * 0.0625f; g.z = logsigmoidf_(acc[q].z) * 0.0625f; g.w = logsigmoidf_(acc[q].w) * 0.0625f;
        *(LAS f32x4*)(gl + (dir * 64 + tok) * 64 + chb + 4 * q) = g; }
    __syncthreads();
    if (tid < 128) { const int d2 = tid >> 6, ch = tid & 63; float run = 0.f;
        for (int i = 0; i < 64; ++i) { const int t = d2 ? 63 - i : i; run += gl[(d2 * 64 + t) * 64 + ch]; gl[(d2 * 64 + t) * 64 + ch] = run; } }
    __syncthreads();
}

__device__ __forceinline__ void gla_stage_vT(Frame& F, const bf16* HQ, int r0, int h, LAS bf16* vT) {
    const int tok = F.tid >> 3, sub = F.tid & 7;
    const bf16* p = HQ + (size_t)(r0 + tok) * NA_IN + HQ_V + 128 * h + 16 * sub; const v4u a = *(const GAS v4u*)p, b = *(const GAS v4u*)(p + 8);
    const unsigned w[8] = {a.x, a.y, a.z, a.w, b.x, b.y, b.z, b.w};
#pragma unroll
    for (int c = 0; c < 8; ++c) { vT[(16 * sub + 2 * c) * 72 + tok] = (bf16)(w[c] & 0xffffu); vT[(16 * sub + 2 * c + 1) * 72 + tok] = (bf16)(w[c] >> 16); }
}

__device__ __forceinline__ void gla_a_phase(Frame& F, int e) {
    const bf16* HQ = (const bf16*)(F.ws + WS_HQ); float* GU = (float*)(F.ws + WS_GLAU); float* GD = (float*)(F.ws + WS_GLAD);
    bf16* AOP1 = (bf16*)(F.ws + WS_AOP1); const bf16* WP = (const bf16*)(F.ws + WS_WPOOL);
    LAS float* gl = (LAS float*)(F.lds + GL_OFF);
    LAS bf16* kdT = (LAS bf16*)(F.lds + GT0);
    LAS bf16* vT = (LAS bf16*)(F.lds + GT0 + 18432);
    LAS bf16* pzs = (LAS bf16*)(F.lds + GT0 + 36864);
    LAS bf16* pooled = (LAS bf16*)(F.lds + GT0 + 57344);
    const int tid = F.tid, lane = F.lane, w = F.wave, fr = lane & 15, fq = lane >> 4;
    for (int unit = blockIdx.x; unit < 768; unit += F.G) {
        const int cg = unit >> 2, h = unit & 3, r0 = cg * 64, uidx = cg * 4 + h;
        int ss, sl; chunk_geom(cg, ss, sl);
        gla_gates(F, e, cg, h, HQ);
        { const int tok = tid >> 3, sub = tid & 7, ch0 = 8 * sub;
          const v4u kq = *(const GAS v4u*)(HQ + (size_t)(r0 + tok) * NA_IN + HQ_K + 64 * h + ch0);
          const float kf[8] = {bflo(kq.x), bfhi(kq.x), bflo(kq.y), bfhi(kq.y), bflo(kq.z), bfhi(kq.z), bflo(kq.w), bfhi(kq.w)};
#pragma unroll
          for (int d2 = 0; d2 < 2; ++d2) { const int tl = d2 ? 0 : 63;
#pragma unroll
              for (int c = 0; c < 8; ++c) { const float bl = gl[(d2 * 64 + tl) * 64 + ch0 + c], bb = gl[(d2 * 64 + tok) * 64 + ch0 + c];
                  kdT[(d2 * 64 + ch0 + c) * 72 + tok] = (bf16)f2bf(kf[c] * __expf(bl - bb)); } }
        }
        gla_stage_vT(F, HQ, r0, h, vT);
        if (tid < 128) { const int d2 = tid >> 6, ch = tid & 63; GD[(size_t)(uidx * 2 + d2) * 64 + ch] = __expf(gl[(d2 * 64 + (d2 ? 0 : 63)) * 64 + ch]); }
        for (int idx = tid; idx < 1280; idx += NTHREADS) { const int rr = idx >> 4, cq = idx & 15, row = r0 - 8 + rr;
            v4u v = {0u, 0u, 0u, 0u}; if (row >= ss && row < ss + sl) v = *(const GAS v4u*)(HQ + (size_t)row * NA_IN + HQ_PZ + 128 * h + 8 * cq);
            *(LAS v4u*)(pzs + rr * 128 + 8 * cq) = v; }
        __syncthreads();
        { const int c = tid & 127, tq = tid >> 7, half = 1 << h;
          for (int t = 16 * tq; t < 16 * tq + 16; ++t) { const int pos = r0 + t - ss; int lo = pos - half, hi = pos + half; lo = lo < 0 ? 0 : lo; hi = hi > sl ? sl : hi;
              float s = 0.f; for (int p = lo; p < hi; ++p) s += bf2f(pzs[(p - pos + t + 8) * 128 + c]);
              pooled[t * 136 + c] = (bf16)f2bf(s / (float)(hi - lo) - bf2f(pzs[(t + 8) * 128 + c])); } }
        { const int d2 = w >> 2, nb = (w & 3) * 2;
          f32x4 acc[4][2];
#pragma unroll
          for (int m = 0; m < 4; ++m) { acc[m][0] = (f32x4){0.f, 0.f, 0.f, 0.f}; acc[m][1] = acc[m][0]; }
#pragma unroll
          for (int ks = 0; ks < 2; ++ks) { bf16x8 b[2];
#pragma unroll
              for (int n = 0; n < 2; ++n) b[n] = ldsfrag(vT, 16 * (nb + n) + fr, 72, 32 * ks + 8 * fq);
#pragma unroll
              for (int m = 0; m < 4; ++m) { const bf16x8 a = ldsfrag(kdT + d2 * 64 * 72, 16 * m + fr, 72, 32 * ks + 8 * fq);
#pragma unroll
                  for (int n = 0; n < 2; ++n) acc[m][n] = mfma16(a, b[n], acc[m][n]); } }
          float* up = GU + (size_t)(uidx * 2 + d2) * 8192;
#pragma unroll
          for (int m = 0; m < 4; ++m)
#pragma unroll
              for (int n = 0; n < 2; ++n)
#pragma unroll
                  for (int r = 0; r < 4; ++r) up[(16 * m + 4 * fq + r) * 128 + 16 * (nb + n) + fr] = acc[m][n][r];
        }
        __syncthreads();
        { f32x4 acc[4];
#pragma unroll
          for (int m = 0; m < 4; ++m) acc[m] = (f32x4){0.f, 0.f, 0.f, 0.f};
          const bf16* wp = WP + (size_t)((e * 4 + h) * 128 + 16 * w + fr) * 128;
#pragma unroll
          for (int ks = 0; ks < 4; ++ks) { const bf16x8 b = *(const GAS bf16x8*)(wp + 32 * ks + 8 * fq);
#pragma unroll
              for (int m = 0; m < 4; ++m) acc[m] = mfma16(ldsfrag(pooled, 16 * m + fr, 136, 32 * ks + 8 * fq), b, acc[m]); }
          const int d = 16 * w + fr; const float sc = inp(F, 17)[(size_t)e * 512 + 128 * h + d];
#pragma unroll
          for (int m = 0; m < 4; ++m)
#pragma unroll
              for (int r = 0; r < 4; ++r) AOP1[(size_t)(r0 + 16 * m + 4 * fq + r) * 1024 + 512 + 128 * h + d] = (bf16)f2bf(acc[m][r] * sc);
        }
        __syncthreads();
    }
}

__device__ __forceinline__ void gla_scan_phase(Frame& F, int e) {
    float* GU = (float*)(F.ws + WS_GLAU); const float* GD = (const float*)(F.ws + WS_GLAD);
    const int lane = F.lane, rsub = lane >> 5, col = 4 * (lane & 31);
    if (F.gw < 512) {
        const int unit = F.gw >> 5, rp = F.gw & 31, row = 2 * rp + rsub, d2 = unit & 1, h = (unit >> 1) & 3, sb = unit >> 3;
        f32x4 S = *(const GAS f32x4*)(inp(F, 2) + ((size_t)(((sb * 2 + e) * 2 + d2) * 4 + h) * 64 + row) * 128 + col);
        for (int g8 = 0; g8 < 4; ++g8) {
            f32x4 U[8]; float dd[8];
#pragma unroll
            for (int i = 0; i < 8; ++i) { const int sc = g8 * 8 + i, ci = d2 ? 31 - sc : sc, cg = 128 + 32 * sb + ci; const size_t ui = (size_t)((cg * 4 + h) * 2 + d2);
                U[i] = *(const GAS f32x4*)(GU + ui * 8192 + row * 128 + col); dd[i] = GD[ui * 64 + row]; }
#pragma unroll
            for (int i = 0; i < 8; ++i) { const int sc = g8 * 8 + i, ci = d2 ? 31 - sc : sc, cg = 128 + 32 * sb + ci; const size_t ui = (size_t)((cg * 4 + h) * 2 + d2);
                *(GAS f32x4*)(GU + ui * 8192 + row * 128 + col) = S; S = S * dd[i] + U[i]; }
        }
    }
    for (int it = F.gw; it < 8192; it += F.NGW) {
        const int unit = it >> 5, rp = it & 31, row = 2 * rp + rsub, d2 = unit & 1, h = (unit >> 1) & 3, s = unit >> 3;
        f32x4 U[4]; float dd[4];
#pragma unroll
        for (int i = 0; i < 4; ++i) { const int ci = d2 ? 3 - i : i, cg = 4 * s + ci; const size_t ui = (size_t)((cg * 4 + h) * 2 + d2);
            U[i] = *(const GAS f32x4*)(GU + ui * 8192 + row * 128 + col); dd[i] = GD[ui * 64 + row]; }
        const float z0 = opaque_zero(); f32x4 S = {z0, z0, z0, z0};
#pragma unroll
        for (int i = 0; i < 4; ++i) { const int ci = d2 ? 3 - i : i, cg = 4 * s + ci; const size_t ui = (size_t)((cg * 4 + h) * 2 + d2);
            *(GAS f32x4*)(GU + ui * 8192 + row * 128 + col) = S; S = S * dd[i] + U[i]; }
        *(GAS f32x4*)(F.out + OUT_GLA + ((size_t)(((s * 2 + e) * 2 + d2) * 4 + h) * 64 + row) * 128 + col) = S;
    }
}

__device__ __forceinline__ void gla_b_phase(Frame& F, int e) {
    const bf16* HQ = (const bf16*)(F.ws + WS_HQ); const float* GU = (const float*)(F.ws + WS_GLAU); bf16* AOP1 = (bf16*)(F.ws + WS_AOP1);
    LAS float* gl = (LAS float*)(F.lds + GL_OFF);
    LAS bf16* att = (LAS bf16*)(F.lds + GL_OFF);
    LAS bf16* qt = (LAS bf16*)(F.lds + GT0);
    LAS bf16* kt = (LAS bf16*)(F.lds + GT0 + 18432);
    LAS bf16* vT = (LAS bf16*)(F.lds + GT0 + 36864);
    LAS bf16* ST = (LAS bf16*)(F.lds + GT0 + 55296);
    LAS float* red = (LAS float*)(F.lds + GT0 + 92160);
    const int tid = F.tid, lane = F.lane, w = F.wave, fr = lane & 15, fq = lane >> 4;
    for (int unit = blockIdx.x; unit < 768; unit += F.G) {
        const int cg = unit >> 2, h = unit & 3, r0 = cg * 64, uidx = cg * 4 + h;
        gla_gates(F, e, cg, h, HQ);
        { const int tok = tid >> 3, sub = tid & 7, ch0 = 8 * sub;
          const v4u qq = *(const GAS v4u*)(HQ + (size_t)(r0 + tok) * NA_IN + 64 * h + ch0), kq = *(const GAS v4u*)(HQ + (size_t)(r0 + tok) * NA_IN + HQ_K + 64 * h + ch0);
          const float qf[8] = {bflo(qq.x), bfhi(qq.x), bflo(qq.y), bfhi(qq.y), bflo(qq.z), bfhi(qq.z), bflo(qq.w), bfhi(qq.w)};
          const float kf[8] = {bflo(kq.x), bfhi(kq.x), bflo(kq.y), bfhi(kq.y), bflo(kq.z), bfhi(kq.z), bflo(kq.w), bfhi(kq.w)};
#pragma unroll
          for (int d2 = 0; d2 < 2; ++d2) { float eb[8];
#pragma unroll
              for (int c = 0; c < 8; ++c) eb[c] = gl[(d2 * 64 + tok) * 64 + ch0 + c];
              v4u oq, ok;
              oq.x = pk2(qf[0] * __expf(eb[0]) * 0.125f, qf[1] * __expf(eb[1]) * 0.125f); oq.y = pk2(qf[2] * __expf(eb[2]) * 0.125f, qf[3] * __expf(eb[3]) * 0.125f);
              oq.z = pk2(qf[4] * __expf(eb[4]) * 0.125f, qf[5] * __expf(eb[5]) * 0.125f); oq.w = pk2(qf[6] * __expf(eb[6]) * 0.125f, qf[7] * __expf(eb[7]) * 0.125f);
              ok.x = pk2(kf[0] * __expf(-eb[0]), kf[1] * __expf(-eb[1])); ok.y = pk2(kf[2] * __expf(-eb[2]), kf[3] * __expf(-eb[3]));
              ok.z = pk2(kf[4] * __expf(-eb[4]), kf[5] * __expf(-eb[5])); ok.w = pk2(kf[6] * __expf(-eb[6]), kf[7] * __expf(-eb[7]));
              *(LAS v4u*)(qt + (d2 * 64 + tok) * 72 + ch0) = oq; *(LAS v4u*)(kt + (d2 * 64 + tok) * 72 + ch0) = ok; }
        }
        gla_stage_vT(F, HQ, r0, h, vT);
#pragma unroll
        for (int j = 0; j < 8; ++j) { const int idx = tid + 512 * j, d2 = idx >> 11, rem = idx & 2047, ch = rem >> 5, dv4 = (rem & 31) * 4;
            const f32x4 s = *(const GAS f32x4*)(GU + (size_t)(uidx * 2 + d2) * 8192 + ch * 128 + dv4);
#pragma unroll
            for (int q = 0; q < 4; ++q) ST[(d2 * 128 + dv4 + q) * 72 + ch] = (bf16)f2bf(s[q]); }
        __syncthreads();
        { const int d2 = w >> 2, mt = w & 3;
          f32x4 acc[4];
#pragma unroll
          for (int n = 0; n < 4; ++n) acc[n] = (f32x4){0.f, 0.f, 0.f, 0.f};
#pragma unroll
          for (int ks = 0; ks < 2; ++ks) { const bf16x8 a = ldsfrag(qt + d2 * 64 * 72, 16 * mt + fr, 72, 32 * ks + 8 * fq);
#pragma unroll
              for (int n = 0; n < 4; ++n) acc[n] = mfma16(a, ldsfrag(kt + d2 * 64 * 72, 16 * n + fr, 72, 32 * ks + 8 * fq), acc[n]); }
#pragma unroll
          for (int n = 0; n < 4; ++n)
#pragma unroll
              for (int r = 0; r < 4; ++r) { const int i = 16 * mt + 4 * fq + r, j = 16 * n + fr; const bool keep = d2 ? (j >= i) : (j <= i);
                  att[(d2 * 64 + i) * 72 + j] = (bf16)f2bf(keep ? acc[n][r] : 0.f); }
        }
        __syncthreads();
        { f32x4 acc[4];
#pragma unroll
          for (int m = 0; m < 4; ++m) acc[m] = (f32x4){0.f, 0.f, 0.f, 0.f};
#pragma unroll
          for (int d2 = 0; d2 < 2; ++d2)
#pragma unroll
              for (int ks = 0; ks < 2; ++ks) { const bf16x8 bv = ldsfrag(vT, 16 * w + fr, 72, 32 * ks + 8 * fq), bs = ldsfrag(ST + d2 * 128 * 72, 16 * w + fr, 72, 32 * ks + 8 * fq);
#pragma unroll
                  for (int m = 0; m < 4; ++m) { acc[m] = mfma16(ldsfrag(att + d2 * 64 * 72, 16 * m + fr, 72, 32 * ks + 8 * fq), bv, acc[m]);
                      acc[m] = mfma16(ldsfrag(qt + d2 * 64 * 72, 16 * m + fr, 72, 32 * ks + 8 * fq), bs, acc[m]); } }
#pragma unroll
          for (int m = 0; m < 4; ++m)
#pragma unroll
              for (int r = 0; r < 4; ++r) { float s = acc[m][r] * acc[m][r]; s += __shfl_xor(s, 1); s += __shfl_xor(s, 2); s += __shfl_xor(s, 4); s += __shfl_xor(s, 8);
                  if (fr == 0) red[w * 64 + 16 * m + 4 * fq + r] = s; }
          __syncthreads();
          const int dv = 16 * w + fr; const float gn = inp(F, 15)[(size_t)e * 128 + dv];
#pragma unroll
          for (int m = 0; m < 4; ++m)
#pragma unroll
              for (int r = 0; r < 4; ++r) { const int t = 16 * m + 4 * fq + r; float s = 0.f;
#pragma unroll
                  for (int ww = 0; ww < 8; ++ww) s += red[ww * 64 + t];
                  const float rstd = 1.f / sqrtf(s * (1.f / 128.f) + EPS);
                  const float rg = bf2f(HQ[(size_t)(r0 + t) * NA_IN + HQ_R + 128 * h + dv]);
                  AOP1[(size_t)(r0 + t) * 1024 + 128 * h + dv] = (bf16)f2bf(acc[m][r] * rstd * gn * siluf(rg)); }
        }
        __syncthreads();
    }
}
__device__ __forceinline__ f32x4 mfma4f(float a, float b, f32x4 c) { return __builtin_amdgcn_mfma_f32_16x16x4f32(a, b, c, 0, 0, 0); }
constexpr int DP_QN = 0, DP_KN = 17408, DP_VT = 34816, DP_KT = 53248, DP_G = 71680  , DP_TM = 108544  ,
              DP_SM = 141824  , DP_PS = 143360  ;
constexpr int TMS = 65;

__device__ __forceinline__ void dn_tri_inverse(LAS float* Tm, LAS float* Ps, int lane) {
    const int fr = lane & 15, fq = lane >> 4;
    { const int a = fq, c = fr; float x[16];
#pragma unroll
      for (int i = 0; i < 16; ++i) { float acc = (i == c) ? 1.f : 0.f;
#pragma unroll
          for (int j = 0; j < i; ++j) acc -= Tm[(16 * a + i) * TMS + 16 * a + j] * x[j];
          x[i] = acc; }
      LDS_WAIT();
#pragma unroll
      for (int i = 0; i < 16; ++i) Tm[(16 * a + i) * TMS + 16 * a + c] = x[i];
      LDS_WAIT();
    }
#pragma unroll
    for (int a = 1; a < 4; ++a)
#pragma unroll
        for (int b = 0; b < a; ++b) {
            f32x4 p = {0.f, 0.f, 0.f, 0.f};
#pragma unroll
            for (int c = b; c < a; ++c)
#pragma unroll
                for (int ks = 0; ks < 4; ++ks) p = mfma4f(Tm[(16 * a + fr) * TMS + 16 * c + 4 * ks + fq], Tm[(16 * c + 4 * ks + fq) * TMS + 16 * b + fr], p);
#pragma unroll
            for (int r = 0; r < 4; ++r) Ps[(4 * fq + r) * 17 + fr] = p[r];
            LDS_WAIT();
            f32x4 q = {0.f, 0.f, 0.f, 0.f};
#pragma unroll
            for (int ks = 0; ks < 4; ++ks) q = mfma4f(Tm[(16 * a + fr) * TMS + 16 * a + 4 * ks + fq], Ps[(4 * ks + fq) * 17 + fr], q);
#pragma unroll
            for (int r = 0; r < 4; ++r) Tm[(16 * a + 4 * fq + r) * TMS + 16 * b + fr] = -q[r];
            LDS_WAIT();
        }
}

__device__ __forceinline__ void dn_conv16(const bf16* base, bool hp, bool hn, const float* cw  , float (&o)[16]) {
    const v4u c0 = *(const GAS v4u*)base, c1 = *(const GAS v4u*)(base + 8);
    v4u p0 = {0u, 0u, 0u, 0u}, p1 = p0, n0 = p0, n1 = p0;
    if (hp) { p0 = *(const GAS v4u*)(base - 1024); p1 = *(const GAS v4u*)(base - 1024 + 8); }
    if (hn) { n0 = *(const GAS v4u*)(base + 1024); n1 = *(const GAS v4u*)(base + 1024 + 8); }
    const unsigned pw[8] = {p0.x, p0.y, p0.z, p0.w, p1.x, p1.y, p1.z, p1.w}, cc[8] = {c0.x, c0.y, c0.z, c0.w, c1.x, c1.y, c1.z, c1.w}, nw[8] = {n0.x, n0.y, n0.z, n0.w, n1.x, n1.y, n1.z, n1.w};
#pragma unroll
    for (int q = 0; q < 4; ++q) { const f32x4 w0 = *(const GAS f32x4*)(cw + 4 * q), w1 = *(const GAS f32x4*)(cw + 3072 + 4 * q), w2 = *(const GAS f32x4*)(cw + 6144 + 4 * q);
#pragma unroll
        for (int e2 = 0; e2 < 2; ++e2) { const int wi = 2 * q + e2;
            const float v0 = w0[2 * e2] * bflo(pw[wi]) + w1[2 * e2] * bflo(cc[wi]) + w2[2 * e2] * bflo(nw[wi]);
            const float v1 = w0[2 * e2 + 1] * bfhi(pw[wi]) + w1[2 * e2 + 1] * bfhi(cc[wi]) + w2[2 * e2 + 1] * bfhi(nw[wi]);
            o[4 * q + 2 * e2] = siluf(v0); o[4 * q + 2 * e2 + 1] = siluf(v1); } }
}

__device__ __forceinline__ void dn_prep_phase(Frame& F, int o_) {
    const bf16* QKVZ = (const bf16*)(F.ws + WS_QKVZ); const float* AB = (const float*)(F.ws + WS_AB);
    bf16* QN = (bf16*)(F.ws + WS_QN); bf16* KN = (bf16*)(F.ws + WS_KN); bf16* UT = (bf16*)(F.ws + WS_UT); bf16* WN = (bf16*)(F.ws + WS_WN); bf16* AQK = (bf16*)(F.ws + WS_AQK); float* BC = (float*)(F.ws + WS_BCUM);
    LAS bf16* qn = (LAS bf16*)(F.lds + DP_QN); LAS bf16* kn = (LAS bf16*)(F.lds + DP_KN); LAS bf16* vT = (LAS bf16*)(F.lds + DP_VT); LAS bf16* kT = (LAS bf16*)(F.lds + DP_KT);
    LAS float* Gkk = (LAS float*)(F.lds + DP_G); LAS float* Gqk = Gkk + 4096; LAS bf16* TT = (LAS bf16*)(F.lds + DP_G);
    LAS float* Tm = (LAS float*)(F.lds + DP_TM); LAS float* sm = (LAS float*)(F.lds + DP_SM); LAS float* Ps = (LAS float*)(F.lds + DP_PS);
    const int tid = F.tid, lane = F.lane, w = F.wave, fr = lane & 15, fq = lane >> 4;
    const float* cwb = inp(F, 20) + (size_t)o_ * 3 * 3072;
    for (int unit = blockIdx.x; unit < 1536; unit += F.G) {
        const int cg = unit >> 3, h = unit & 7, r0 = cg * 64;
        int ss, sl; chunk_geom(cg, ss, sl);
        { const int tok = tid >> 3, sub = tid & 7, c0 = 16 * sub, row = r0 + tok; const bool hp = row > ss, hn = row < ss + sl - 1;
          const size_t go = (size_t)row * 1024 + 128 * h + c0;
          float v[16];
          dn_conv16(QKVZ + go, hp, hn, cwb + 128 * h + c0, v);
          { float s = 0.f;
#pragma unroll
            for (int c = 0; c < 16; ++c) s += v[c] * v[c];
            s += __shfl_xor(s, 1); s += __shfl_xor(s, 2); s += __shfl_xor(s, 4);
            const float rn = 0.08838834764831845f / sqrtf(s + EPS);
            v4u a, b; a.x = pk2(v[0] * rn, v[1] * rn); a.y = pk2(v[2] * rn, v[3] * rn); a.z = pk2(v[4] * rn, v[5] * rn); a.w = pk2(v[6] * rn, v[7] * rn);
            b.x = pk2(v[8] * rn, v[9] * rn); b.y = pk2(v[10] * rn, v[11] * rn); b.z = pk2(v[12] * rn, v[13] * rn); b.w = pk2(v[14] * rn, v[15] * rn);
            *(LAS v4u*)(qn + tok * 136 + c0) = a; *(LAS v4u*)(qn + tok * 136 + c0 + 8) = b; *(GAS v4u*)(QN + go) = a; *(GAS v4u*)(QN + go + 8) = b; }
          dn_conv16(QKVZ + QKVZ_STRIDE + go, hp, hn, cwb + 1024 + 128 * h + c0, v);
          { float s = 0.f;
#pragma unroll
            for (int c = 0; c < 16; ++c) s += v[c] * v[c];
            s += __shfl_xor(s, 1); s += __shfl_xor(s, 2); s += __shfl_xor(s, 4);
            const float rn = 1.f / sqrtf(s + EPS);
            v4u a, b; a.x = pk2(v[0] * rn, v[1] * rn); a.y = pk2(v[2] * rn, v[3] * rn); a.z = pk2(v[4] * rn, v[5] * rn); a.w = pk2(v[6] * rn, v[7] * rn);
            b.x = pk2(v[8] * rn, v[9] * rn); b.y = pk2(v[10] * rn, v[11] * rn); b.z = pk2(v[12] * rn, v[13] * rn); b.w = pk2(v[14] * rn, v[15] * rn);
            *(LAS v4u*)(kn + tok * 136 + c0) = a; *(LAS v4u*)(kn + tok * 136 + c0 + 8) = b; *(GAS v4u*)(KN + go) = a; *(GAS v4u*)(KN + go + 8) = b;
            const unsigned ww[8] = {a.x, a.y, a.z, a.w, b.x, b.y, b.z, b.w};
#pragma unroll
            for (int c = 0; c < 8; ++c) { kT[(c0 + 2 * c) * 72 + tok] = (bf16)(ww[c] & 0xffffu); kT[(c0 + 2 * c + 1) * 72 + tok] = (bf16)(ww[c] >> 16); } }
          dn_conv16(QKVZ + 2 * QKVZ_STRIDE + go, hp, hn, cwb + 2048 + 128 * h + c0, v);
#pragma unroll
          for (int c = 0; c < 16; ++c) vT[(c0 + c) * 72 + tok] = (bf16)f2bf(v[c]);
        }
        if (w < 2) { const int d2 = w, i = lane, tok = d2 ? 63 - i : i, row = r0 + tok;
            const float a = AB[(size_t)row * 32 + d2 * 8 + h], bt = AB[(size_t)row * 32 + 16 + d2 * 8 + h];
            const float g = -expf(inp(F, 21)[(size_t)(o_ * 2 + d2) * 8 + h]) * softplusf_(a + inp(F, 22)[(size_t)(o_ * 2 + d2) * 8 + h]);
            float b = g;
#pragma unroll
            for (int o = 1; o < 64; o <<= 1) { const float t = __shfl_up(b, o); if (lane >= o) b += t; }
            sm[d2 * 64 + i] = sigmoidf_(bt); sm[128 + d2 * 64 + i] = b;
            BC[(size_t)((cg * 8 + h) * 2 + d2) * 64 + i] = b; }
        __syncthreads();
        { const int which = w >> 2, mt = w & 3; const LAS bf16* As = which ? qn : kn; LAS float* Gd = which ? Gqk : Gkk;
          f32x4 acc[4];
#pragma unroll
          for (int n = 0; n < 4; ++n) acc[n] = (f32x4){0.f, 0.f, 0.f, 0.f};
#pragma unroll
          for (int ks = 0; ks < 4; ++ks) { const bf16x8 a = ldsfrag(As, 16 * mt + fr, 136, 32 * ks + 8 * fq);
#pragma unroll
              for (int n = 0; n < 4; ++n) acc[n] = mfma16(a, ldsfrag(kn, 16 * n + fr, 136, 32 * ks + 8 * fq), acc[n]); }
#pragma unroll
          for (int n = 0; n < 4; ++n)
#pragma unroll
              for (int r = 0; r < 4; ++r) Gd[(16 * mt + 4 * fq + r) * 64 + 16 * n + fr] = acc[n][r];
        }
        __syncthreads();
#pragma unroll 4
        for (int t = 0; t < 16; ++t) { const int idx = tid + 512 * t, d2 = idx >> 12, i = (idx >> 6) & 63, j = idx & 63, ti = d2 ? 63 - i : i, tj = d2 ? 63 - j : j;
            const float bi = sm[128 + d2 * 64 + i], bj = sm[128 + d2 * 64 + j], ee = (j <= i) ? __expf(bi - bj) : 0.f;
            Tm[(d2 * 64 + i) * TMS + j] = (j < i) ? sm[d2 * 64 + i] * Gkk[ti * 64 + tj] * ee : 0.f;
            AQK[(size_t)((cg * 8 + h) * 2 + d2) * 4096 + i * 64 + j] = (bf16)f2bf(Gqk[ti * 64 + tj] * ee); }
        __syncthreads();
        if (w < 2) dn_tri_inverse(Tm + w * 64 * TMS, Ps + w * 16 * 17, lane);
        __syncthreads();
#pragma unroll 4
        for (int t = 0; t < 16; ++t) { const int idx = tid + 512 * t, d2 = idx >> 12, i = (idx >> 6) & 63, j = idx & 63, jc = d2 ? 63 - j : j;
            const float tv = Tm[(d2 * 64 + i) * TMS + j] * sm[d2 * 64 + j];
            TT[((d2 * 2 + 0) * 64 + i) * 72 + jc] = (bf16)f2bf(tv); TT[((d2 * 2 + 1) * 64 + i) * 72 + jc] = (bf16)f2bf(tv * __expf(sm[128 + d2 * 64 + j])); }
        __syncthreads();
        { const int d2 = w >> 2, sb = w & 3; const size_t ud = (size_t)((cg * 8 + h) * 2 + d2);
          const LAS bf16* T0 = TT + (d2 * 2 + 0) * 64 * 72; const LAS bf16* T1 = TT + (d2 * 2 + 1) * 64 * 72;
          { f32x4 acc[4][2];
#pragma unroll
            for (int m = 0; m < 4; ++m) { acc[m][0] = (f32x4){0.f, 0.f, 0.f, 0.f}; acc[m][1] = acc[m][0]; }
#pragma unroll
            for (int ks = 0; ks < 2; ++ks) { bf16x8 b[2];
#pragma unroll
                for (int n = 0; n < 2; ++n) b[n] = ldsfrag(vT, 16 * (2 * sb + n) + fr, 72, 32 * ks + 8 * fq);
#pragma unroll
                for (int m = 0; m < 4; ++m) { const bf16x8 a = ldsfrag(T0, 16 * m + fr, 72, 32 * ks + 8 * fq);
#pragma unroll
                    for (int n = 0; n < 2; ++n) acc[m][n] = mfma16(a, b[n], acc[m][n]); } }
#pragma unroll
            for (int m = 0; m < 4; ++m)
#pragma unroll
                for (int n = 0; n < 2; ++n) { v2u o; o.x = pk2(acc[m][n][0], acc[m][n][1]); o.y = pk2(acc[m][n][2], acc[m][n][3]);
                    *(GAS v2u*)(UT + ud * 8192 + (size_t)(16 * (2 * sb + n) + fr) * 64 + 16 * m + 4 * fq) = o; }
          }
          { f32x4 acc[2][4];
#pragma unroll
            for (int m = 0; m < 2; ++m)
#pragma unroll
                for (int n = 0; n < 4; ++n) acc[m][n] = (f32x4){0.f, 0.f, 0.f, 0.f};
#pragma unroll
            for (int ks = 0; ks < 2; ++ks) { bf16x8 a[2];
#pragma unroll
                for (int m = 0; m < 2; ++m) a[m] = ldsfrag(kT, 16 * (2 * sb + m) + fr, 72, 32 * ks + 8 * fq);
#pragma unroll
                for (int n = 0; n < 4; ++n) { const bf16x8 b = ldsfrag(T1, 16 * n + fr, 72, 32 * ks + 8 * fq);
#pragma unroll
                    for (int m = 0; m < 2; ++m) acc[m][n] = mfma16(a[m], b, acc[m][n]); } }
#pragma unroll
            for (int m = 0; m < 2; ++m)
#pragma unroll
                for (int n = 0; n < 4; ++n) { v2u o; o.x = pk2(-acc[m][n][0], -acc[m][n][1]); o.y = pk2(-acc[m][n][2], -acc[m][n][3]);
                    *(GAS v2u*)(WN + ud * 8192 + (size_t)(16 * n + fr) * 128 + 16 * (2 * sb + m) + 4 * fq) = o; }
          }
        }
        __syncthreads();
    }
}

constexpr int DS_WL = 0, DS_QD = 17408, DS_KDT = 34816, DS_AQ = 53248;
__device__ __forceinline__ void dn_scan_phase(Frame& F, int o_) {
    const bf16* QN = (const bf16*)(F.ws + WS_QN); const bf16* KN = (const bf16*)(F.ws + WS_KN); const bf16* UT = (const bf16*)(F.ws + WS_UT); const bf16* WN = (const bf16*)(F.ws + WS_WN);
    const bf16* AQK = (const bf16*)(F.ws + WS_AQK); const float* BC = (const float*)(F.ws + WS_BCUM);
    LAS bf16* wl = (LAS bf16*)(F.lds + DS_WL); LAS bf16* qd = (LAS bf16*)(F.lds + DS_QD); LAS bf16* kdT = (LAS bf16*)(F.lds + DS_KDT); LAS bf16* aq = (LAS bf16*)(F.lds + DS_AQ);
    const int tid = F.tid, lane = F.lane, w = F.wave, fr = lane & 15, fq = lane >> 4;
    for (int item = blockIdx.x; item < 544; item += F.G) {
        int s, h, d2, nchunk, cg0;
        if (item < 32) { const int sb = item >> 4; h = (item >> 1) & 7; d2 = item & 1; s = 32 + sb; nchunk = 32; cg0 = 128 + 32 * sb; }
        else { const int u = item - 32; s = u >> 4; h = (u >> 1) & 7; d2 = u & 1; nchunk = 4; cg0 = 4 * s; }
        bf16* OD = (bf16*)(F.ws + (d2 ? WS_OB : WS_OF));
        const int dv = 16 * w + fr;
        f32x4 S[8];
        if (s >= 32) { const float* sp = inp(F, 3) + (size_t)((((s - 32) * 2 + o_) * 2 + d2) * 8 + h) * 16384;
#pragma unroll
            for (int t = 0; t < 8; ++t)
#pragma unroll
                for (int r = 0; r < 4; ++r) S[t][r] = sp[(16 * t + 4 * fq + r) * 128 + dv];
        } else {
#pragma unroll
            for (int t = 0; t < 8; ++t) S[t] = (f32x4){0.f, 0.f, 0.f, 0.f};
        }
        for (int sc = 0; sc < nchunk; ++sc) {
            const int ci = d2 ? nchunk - 1 - sc : sc, cg = cg0 + ci, r0 = cg * 64; const size_t ud = (size_t)((cg * 8 + h) * 2 + d2);
            const float blast = BC[ud * 64 + 63];
            { const int i = tid >> 3, sub = tid & 7, c0 = 16 * sub, row = r0 + (d2 ? 63 - i : i); const float bi = BC[ud * 64 + i], eq = __expf(bi), ek = __expf(blast - bi);
              const bf16* wp = WN + ud * 8192 + (size_t)i * 128 + c0;
              *(LAS v4u*)(wl + i * 136 + c0) = *(const GAS v4u*)wp; *(LAS v4u*)(wl + i * 136 + c0 + 8) = *(const GAS v4u*)(wp + 8);
              const bf16* qp = QN + (size_t)row * 1024 + 128 * h + c0; const v4u q0 = *(const GAS v4u*)qp, q1 = *(const GAS v4u*)(qp + 8);
              v4u a, b; a.x = pk2(bflo(q0.x) * eq, bfhi(q0.x) * eq); a.y = pk2(bflo(q0.y) * eq, bfhi(q0.y) * eq); a.z = pk2(bflo(q0.z) * eq, bfhi(q0.z) * eq); a.w = pk2(bflo(q0.w) * eq, bfhi(q0.w) * eq);
              b.x = pk2(bflo(q1.x) * eq, bfhi(q1.x) * eq); b.y = pk2(bflo(q1.y) * eq, bfhi(q1.y) * eq); b.z = pk2(bflo(q1.z) * eq, bfhi(q1.z) * eq); b.w = pk2(bflo(q1.w) * eq, bfhi(q1.w) * eq);
              *(LAS v4u*)(qd + i * 136 + c0) = a; *(LAS v4u*)(qd + i * 136 + c0 + 8) = b;
              const bf16* kp = KN + (size_t)row * 1024 + 128 * h + c0; const v4u k0 = *(const GAS v4u*)kp, k1 = *(const GAS v4u*)(kp + 8);
              const unsigned kw[8] = {k0.x, k0.y, k0.z, k0.w, k1.x, k1.y, k1.z, k1.w};
#pragma unroll
              for (int c = 0; c < 8; ++c) { kdT[(c0 + 2 * c) * 72 + i] = (bf16)f2bf(bflo(kw[c]) * ek); kdT[(c0 + 2 * c + 1) * 72 + i] = (bf16)f2bf(bfhi(kw[c]) * ek); }
              *(LAS v4u*)(aq + (tid >> 3) * 72 + 8 * (tid & 7)) = *(const GAS v4u*)(AQK + ud * 4096 + (size_t)tid * 8);
            }
            f32x4 vacc[4];
#pragma unroll
            for (int m = 0; m < 4; ++m) { const v2u uu = *(const GAS v2u*)(UT + ud * 8192 + (size_t)dv * 64 + 16 * m + 4 * fq); vacc[m] = (f32x4){bflo(uu.x), bfhi(uu.x), bflo(uu.y), bfhi(uu.y)}; }
            __syncthreads();
            bf16x8 sf[4];
#pragma unroll
            for (int T = 0; T < 4; ++T) sf[T] = acc2frag(S[2 * T], S[2 * T + 1]);
            f32x4 oacc[4];
#pragma unroll
            for (int m = 0; m < 4; ++m) { oacc[m] = (f32x4){0.f, 0.f, 0.f, 0.f};
#pragma unroll
                for (int T = 0; T < 4; ++T) { vacc[m] = mfma16(ldsfrag_perm(wl, 16 * m + fr, 136, 32 * T, fq), sf[T], vacc[m]); oacc[m] = mfma16(ldsfrag_perm(qd, 16 * m + fr, 136, 32 * T, fq), sf[T], oacc[m]); } }
            bf16x8 vf[2];
#pragma unroll
            for (int T = 0; T < 2; ++T) vf[T] = acc2frag(vacc[2 * T], vacc[2 * T + 1]);
#pragma unroll
            for (int m = 0; m < 4; ++m)
#pragma unroll
                for (int T = 0; T < 2; ++T) oacc[m] = mfma16(ldsfrag_perm(aq, 16 * m + fr, 72, 32 * T, fq), vf[T], oacc[m]);
            const float dec = __expf(blast);
#pragma unroll
            for (int t = 0; t < 8; ++t) { S[t] = S[t] * dec;
#pragma unroll
                for (int T = 0; T < 2; ++T) S[t] = mfma16(ldsfrag_perm(kdT, 16 * t + fr, 72, 32 * T, fq), vf[T], S[t]); }
#pragma unroll
            for (int m = 0; m < 4; ++m)
#pragma unroll
                for (int r = 0; r < 4; ++r) { const int i = 16 * m + 4 * fq + r, row = r0 + (d2 ? 63 - i : i); OD[(size_t)row * 1024 + 128 * h + dv] = (bf16)f2bf(oacc[m][r]); }
            __syncthreads();
        }
        if (s < 32) { float* op = F.out + OUT_DN + (size_t)(((s * 2 + o_) * 2 + d2) * 8 + h) * 16384;
#pragma unroll
            for (int t = 0; t < 8; ++t)
#pragma unroll
                for (int r = 0; r < 4; ++r) op[(16 * t + 4 * fq + r) * 128 + dv] = S[t][r]; }
    }
}

__device__ __forceinline__ void dn_combine_phase(Frame& F, int o_) {
    const bf16* OF = (const bf16*)(F.ws + WS_OF); const bf16* OB = (const bf16*)(F.ws + WS_OB); const bf16* Z = (const bf16*)(F.ws + WS_QKVZ) + 3 * QKVZ_STRIDE; bf16* AOP1 = (bf16*)(F.ws + WS_AOP1);
    const int lane = F.lane, c0 = 16 * lane;
    f32x4 gn[4];
#pragma unroll
    for (int q = 0; q < 4; ++q) gn[q] = *(const GAS f32x4*)(inp(F, 23) + (size_t)o_ * 128 + (c0 & 127) + 4 * q);
    for (int m = F.gw; m < M; m += F.NGW) {
        const size_t go = (size_t)m * 1024 + c0;
        const v4u a0 = *(const GAS v4u*)(OF + go), a1 = *(const GAS v4u*)(OF + go + 8), b0 = *(const GAS v4u*)(OB + go), b1 = *(const GAS v4u*)(OB + go + 8), z0 = *(const GAS v4u*)(Z + go), z1 = *(const GAS v4u*)(Z + go + 8);
        const unsigned aw[8] = {a0.x, a0.y, a0.z, a0.w, a1.x, a1.y, a1.z, a1.w}, bw[8] = {b0.x, b0.y, b0.z, b0.w, b1.x, b1.y, b1.z, b1.w}, zw[8] = {z0.x, z0.y, z0.z, z0.w, z1.x, z1.y, z1.z, z1.w};
        float o[16]; float s = 0.f;
#pragma unroll
        for (int c = 0; c < 8; ++c) { o[2 * c] = bflo(aw[c]) + bflo(bw[c]); o[2 * c + 1] = bfhi(aw[c]) + bfhi(bw[c]); s += o[2 * c] * o[2 * c] + o[2 * c + 1] * o[2 * c + 1]; }
        s += __shfl_xor(s, 1); s += __shfl_xor(s, 2); s += __shfl_xor(s, 4);
        const float rstd = 1.f / sqrtf(s * (1.f / 128.f) + EPS);
        unsigned ow[8];
#pragma unroll
        for (int c = 0; c < 8; ++c) ow[c] = pk2(o[2 * c] * rstd * gn[c >> 1][2 * (c & 1)] * siluf(bflo(zw[c])), o[2 * c + 1] * rstd * gn[c >> 1][2 * (c & 1) + 1] * siluf(bfhi(zw[c])));
        *(GAS v4u*)(AOP1 + go) = (v4u){ow[0], ow[1], ow[2], ow[3]}; *(GAS v4u*)(AOP1 + go + 8) = (v4u){ow[4], ow[5], ow[6], ow[7]};
    }
}
struct Args { const float* in[28]; float* out; unsigned char* ws; int ph_lo, ph_hi; };
constexpr int NPHASES = 2 + 10 * DEPTH;

__global__ void __launch_bounds__(NTHREADS, 2) fwd_mega(Args args) {
    extern __shared__ __attribute__((aligned(16))) unsigned char lds_raw[];
    Frame F;
    F.lds = (LAS unsigned char*)lds_raw;
    F.tid = threadIdx.x; F.lane = F.tid & 63; F.wave = __builtin_amdgcn_readfirstlane(F.tid >> 6);
    F.G = gridDim.x; F.gw = blockIdx.x * NWAVES + F.wave; F.NGW = F.G * NWAVES;
    F.out = args.out; F.ws = args.ws;
    volatile LAS unsigned* MISC = (volatile LAS unsigned*)(F.lds + LDSCTL_OFF);
    for (int u = F.tid; u < 16; u += NTHREADS) MISC[u] = 0u;
    if (F.tid == 0) { LAS unsigned long long* tab = (LAS unsigned long long*)(F.lds + INTAB_OFF);
#pragma unroll
        for (int i = 0; i < 28; ++i) tab[i] = (unsigned long long)args.in[i]; }
    __syncthreads();
    const int lo = args.ph_lo, hi = args.ph_hi;
    const bool multi = (hi - lo) > 1;
    XcdBarrier bar; bar.bar = (unsigned*)(F.ws + WS_CTL) + CW_BAR; bar.x = 0; bar.st = nullptr;
    if (multi) bar = xcd_barrier_post((unsigned*)(F.ws + WS_CTL) + CW_BAR, MISC + 8);
#define IN(k) (lo <= (k) && (k) < hi && (frame_refresh(F), true))
#define SEAM(k) do { if (IN((k) + 1)) xcd_barrier(bar); } while (0)
    float* X = F.out; float* V = (float*)(F.ws + WS_V); bf16* U = (bf16*)(F.ws + WS_U);
    const float* MOD = (const float*)(F.ws + WS_MOD);
    bf16* AOP1 = (bf16*)(F.ws + WS_AOP1); bf16* AOP2 = (bf16*)(F.ws + WS_AOP2); bf16* H = (bf16*)(F.ws + WS_H);

    if (IN(0)) { p0_prologue(F); SEAM(0); }
    if (IN(1)) { rows_ln_mod<false, true>(F, X, nullptr, nullptr, nullptr, MOD + 1024, MOD, U); SEAM(1); }
#pragma unroll 1
    for (int l = 0; l < DEPTH; ++l) {
        const int pb = 2 + 10 * l, eo = l >> 1;
        const float* modl = MOD + (size_t)l * 3 * 6144;
        if (IN(pb + 0)) {
            if ((l & 1) == 0) {
                pg8::Gemm g{U, (const bf16*)(F.ws + WS_WA_IN) + (size_t)eo * NA_IN * 1024, M, NA_IN, 1024}; pg8::StaticOrder S; S.init(M, NA_IN, F.G, (int)blockIdx.x);
                pg8::EpiBf16<0> E{(bf16*)(F.ws + WS_HQ), NA_IN, nullptr, 0, 0, 1.f};
                pg8::gemm_phase<pg8::EpiBf16<0>, pg8::StaticOrder, true, true>(F.lds, g, S, E);
            } else {
                const bf16* Wc = (const bf16*)(F.ws + WS_WC_IN + eo * WC_IN_STRIDE);
                pg8::Gemm g{U, Wc, M, 4096, 1024}; pg8::StaticOrder S; S.init(M, 4096, F.G, (int)blockIdx.x);
                pg8::EpiBf16<0> E{(bf16*)(F.ws + WS_QKVZ), 1024, nullptr, 1024, QKVZ_STRIDE, 1.f};
                pg8::gemm_phase<pg8::EpiBf16<0>, pg8::StaticOrder, true, true>(F.lds, g, S, E);
                __syncthreads();
                skinny_gemm(F, U, Wc + (size_t)4096 * 1024, (float*)(F.ws + WS_AB));
            }
            SEAM(pb + 0);
        }
        if (IN(pb + 1)) { if ((l & 1) == 0) gla_a_phase(F, eo); else dn_prep_phase(F, eo); SEAM(pb + 1); }
        if (IN(pb + 2)) { if ((l & 1) == 0) gla_scan_phase(F, eo); else dn_scan_phase(F, eo); SEAM(pb + 2); }
        if (IN(pb + 3)) { if ((l & 1) == 0) gla_b_phase(F, eo); else dn_combine_phase(F, eo); SEAM(pb + 3); }
        if (IN(pb + 4)) {
            const bf16* Wo = (l & 1) ? (const bf16*)(F.ws + WS_WC_OUT) + (size_t)eo * 1024 * 1024 : (const bf16*)(F.ws + WS_WA_OUT) + (size_t)eo * 1024 * 1024;
            pg8::Gemm g{AOP1, Wo, M, 1024, 1024}; pg8::StaticOrder S; S.init(M, 1024, F.G, (int)blockIdx.x);
            EpiRes E{X, V, modl + 2048};
            pg8::gemm_phase<EpiRes, pg8::StaticOrder, true, true>(F.lds, g, S, E);
            SEAM(pb + 4);
        }
        if (IN(pb + 5)) { rows_ln_mod<true, true>(F, V, inp(F, 8) + (size_t)l * 1024, inp(F, 9) + (size_t)l * 1024, X, modl + 4096, modl + 3072, U); SEAM(pb + 5); }
        if (IN(pb + 6)) {
            pg8::Gemm g{U, (const bf16*)(F.ws + WS_WUP) + (size_t)l * 5632 * 1024, M, 5632, 1024}; pg8::StaticOrder S; S.init(M, 5632, F.G, (int)blockIdx.x);
            pg8::EpiBf16<0> E{H, 5632, nullptr, 0, 0, 1.f};
            pg8::gemm_phase<pg8::EpiBf16<0>, pg8::StaticOrder, true, true>(F.lds, g, S, E);
            SEAM(pb + 6);
        }
        if (IN(pb + 7)) { conv_gate_phase(F, H, inp(F, 26) + (size_t)l * 3 * 5632, AOP2); SEAM(pb + 7); }
        if (IN(pb + 8)) {
            pg8::Gemm g{AOP2, (const bf16*)(F.ws + WS_WDOWN) + (size_t)l * 1024 * 2816, M, 1024, 2816}; pg8::StaticOrder S; S.init(M, 1024, F.G, (int)blockIdx.x);
            EpiRes E{X, V, modl + 5120};
            pg8::gemm_phase<EpiRes, pg8::StaticOrder, true, true>(F.lds, g, S, E);
            SEAM(pb + 8);
        }
        if (IN(pb + 9)) {
            if (l + 1 < DEPTH) rows_ln_mod<true, true>(F, V, inp(F, 10) + (size_t)l * 1024, inp(F, 11) + (size_t)l * 1024, X, modl + 18432 + 1024, modl + 18432, U);
            else rows_ln_mod<true, false>(F, V, inp(F, 10) + (size_t)l * 1024, inp(F, 11) + (size_t)l * 1024, X, nullptr, nullptr, nullptr);
            SEAM(pb + 9);
        }
    }
#undef IN
#undef SEAM
}

#ifndef MK_PER_PHASE
#define MK_PER_PHASE 0
#endif
extern "C" void kernel_launch(void* const* d_in, const int* in_sizes, int n_in, void* d_out, int out_size, void* d_ws, size_t ws_size, hipStream_t stream) {
    static int grid = 0;
    if (grid == 0) {
        if (n_in != 28 || out_size != 33554432 || ws_size < WS_END) { fprintf(stderr, "kernel_launch: unexpected shapes (n_in %d out %d ws %zu)\n", n_in, out_size, ws_size); grid = -1; return; }
        int dev = 0, cus = 0;
        if (hipGetDevice(&dev) != hipSuccess || hipDeviceGetAttribute(&cus, hipDeviceAttributeMultiprocessorCount, dev) != hipSuccess) { grid = -1; return; }
        if (hipFuncSetAttribute((const void*)fwd_mega, hipFuncAttributeMaxDynamicSharedMemorySize, LDS_BYTES) != hipSuccess) { fprintf(stderr, "kernel_launch: hipFuncSetAttribute failed\n"); grid = -1; return; }
        int per_cu = 0;
        if (hipOccupancyMaxActiveBlocksPerMultiprocessor(&per_cu, (const void*)fwd_mega, NTHREADS, LDS_BYTES) != hipSuccess || per_cu < 1) { fprintf(stderr, "kernel_launch: occupancy query says %d\n", per_cu); }
        (void)hipGetLastError();
        grid = cus;
    }
    if (grid < 0) return;
    (void)hipMemsetAsync((char*)d_ws + WS_CTL, 0, CTL_ZERO_BYTES, stream);
    Args a{};
    for (int i = 0; i < 28; ++i) a.in[i] = (const float*)d_in[i];
    a.out = (float*)d_out; a.ws = (unsigned char*)d_ws;
#if MK_PER_PHASE
    for (int p = 0; p < NPHASES; ++p) { a.ph_lo = p; a.ph_hi = p + 1; hipLaunchKernelGGL(fwd_mega, dim3(grid), dim3(NTHREADS), LDS_BYTES, stream, a); }
#else
    a.ph_lo = 0; a.ph_hi = NPHASES;
    hipLaunchKernelGGL(fwd_mega, dim3(grid), dim3(NTHREADS), LDS_BYTES, stream, a);
#endif
}
```
